# Optimizing an MI355X kernel written in HIP

```python
import jax, jax.numpy as jnp
from jax import lax
import numpy as np

D_MODEL = 1024
BATCH = 8
SEQ = 2048
DEPTH = 4

N_A = DEPTH // 2
N_B = DEPTH - N_A
N_HEADS = 16
HEAD_DIM = D_MODEL // N_HEADS
D_FF = 2816
CONV_WIDTH = 31
Q_BLOCK = 128
RMS_EPS = 1e-6
LN_EPS = 1e-5
HALF_STEP = 0.5

kernel_name = "conformer_conv_stickbreaking_yoco"


def rms_norm(x, g):
    xf = x.astype(jnp.float32)
    y = xf * lax.rsqrt(jnp.mean(xf * xf, axis=-1, keepdims=True) + RMS_EPS)
    return (y * g.astype(jnp.float32)).astype(x.dtype)


def layer_norm(x, g, b):
    xf = x.astype(jnp.float32)
    mu = jnp.mean(xf, axis=-1, keepdims=True)
    xc = xf - mu
    var = jnp.mean(xc * xc, axis=-1, keepdims=True)
    y = xc * lax.rsqrt(var + LN_EPS) * g.astype(jnp.float32) + b.astype(jnp.float32)
    return y.astype(x.dtype)


def swiglu_ffn(x, w_gate, w_up, w_down):
    return (jax.nn.silu(x @ w_gate) * (x @ w_up)) @ w_down


def conformer_conv(x, w_pw1, b_pw1, w_dw, b_dw, ln_g, ln_b, w_pw2, b_pw2):
    h = x @ w_pw1 + b_pw1
    a, gate = jnp.split(h, 2, axis=-1)
    h = a * jax.nn.sigmoid(gate)
    h = lax.conv_general_dilated(
        h, w_dw[:, None, :].astype(h.dtype),
        window_strides=(1,), padding=[(CONV_WIDTH - 1, 0)],
        dimension_numbers=('NWC', 'WIO', 'NWC'),
        feature_group_count=D_MODEL) + b_dw
    h = jax.nn.silu(layer_norm(h, ln_g, ln_b))
    return h @ w_pw2 + b_pw2


def split_heads(t):
    b, s, _ = t.shape
    return t.reshape(b, s, N_HEADS, HEAD_DIM).transpose(0, 2, 1, 3)


def stick_breaking_attention(q, k, v):
    s_len = q.shape[2]
    scale = HEAD_DIM ** -0.5
    outs = []
    for blk in range(s_len // Q_BLOCK):
        start = blk * Q_BLOCK
        end = start + Q_BLOCK
        qb = q[:, :, start:end]
        kb = k[:, :, :end]
        vb = v[:, :, :end]
        z = jnp.einsum('bhqd,bhkd->bhqk', qb, kb, preferred_element_type=jnp.float32) * scale
        t_pos = jnp.arange(start, end)[:, None]
        s_pos = jnp.arange(end)[None, :]
        causal = s_pos < t_pos
        log_beta = jax.nn.log_sigmoid(z)
        log_one_minus = jnp.where(causal, jax.nn.log_sigmoid(-z), 0.0)
        log_remain = lax.cumsum(log_one_minus, axis=3, reverse=True) - log_one_minus
        weights = jnp.where(causal, jnp.exp(log_beta + log_remain), 0.0)
        outs.append(jnp.einsum('bhqk,bhkd->bhqd', weights.astype(vb.dtype), vb))
    return jnp.concatenate(outs, axis=2)


def setup_inputs(seed: int = 0) -> dict:
    key = jax.random.key(seed)
    ks = jax.random.split(key, 32)
    f32 = jnp.float32

    def w(k, shape, fan_in):
        return jax.random.normal(k, shape, f32) * (fan_in ** -0.5)

    def gain(k, shape):
        return 1.0 + 0.02 * jax.random.normal(k, shape, f32)

    def bias(k, shape):
        return 0.01 * jax.random.normal(k, shape, f32)

    D, F = D_MODEL, D_FF
    return {
        "x": jax.random.normal(ks[0], (BATCH, SEQ, D), f32),
        "ffn1_norm": gain(ks[1], (DEPTH, D)),
        "ffn1_w_gate": w(ks[2], (DEPTH, D, F), D),
        "ffn1_w_up": w(ks[3], (DEPTH, D, F), D),
        "ffn1_w_down": w(ks[4], (DEPTH, F, D), F),
        "mix_norm": gain(ks[5], (DEPTH, D)),
        "ffn2_norm": gain(ks[6], (DEPTH, D)),
        "ffn2_w_gate": w(ks[7], (DEPTH, D, F), D),
        "ffn2_w_up": w(ks[8], (DEPTH, D, F), D),
        "ffn2_w_down": w(ks[9], (DEPTH, F, D), F),
        "conv_w_pw1": w(ks[10], (N_A, D, 2 * D), D),
        "conv_b_pw1": bias(ks[11], (N_A, 2 * D)),
        "conv_w_dw": w(ks[12], (N_A, CONV_WIDTH, D), CONV_WIDTH),
        "conv_b_dw": bias(ks[13], (N_A, D)),
        "conv_ln_g": gain(ks[14], (N_A, D)),
        "conv_ln_b": bias(ks[15], (N_A, D)),
        "conv_w_pw2": w(ks[16], (N_A, D, D), D),
        "conv_b_pw2": bias(ks[17], (N_A, D)),
        "kv_norm": gain(ks[18], (D,)),
        "w_kv": w(ks[19], (D, 2 * D), D),
        "attn_w_q": w(ks[20], (N_B, D, D), D),
        "attn_w_o": w(ks[21], (N_B, D, D), D),
        "final_norm": gain(ks[22], (D,)),
    }


def reference(x, ffn1_norm, ffn1_w_gate, ffn1_w_up, ffn1_w_down, mix_norm,
              ffn2_norm, ffn2_w_gate, ffn2_w_up, ffn2_w_down,
              conv_w_pw1, conv_b_pw1, conv_w_dw, conv_b_dw, conv_ln_g, conv_ln_b,
              conv_w_pw2, conv_b_pw2, kv_norm, w_kv, attn_w_q, attn_w_o, final_norm):
    b, s, d = x.shape
    h = x
    k_shared = None
    v_shared = None
    for layer in range(DEPTH):
        h = h + HALF_STEP * swiglu_ffn(rms_norm(h, ffn1_norm[layer]),
                                       ffn1_w_gate[layer], ffn1_w_up[layer], ffn1_w_down[layer])
        u = rms_norm(h, mix_norm[layer])
        if layer < N_A:
            i = layer
            h = h + conformer_conv(u, conv_w_pw1[i], conv_b_pw1[i], conv_w_dw[i], conv_b_dw[i],
                                   conv_ln_g[i], conv_ln_b[i], conv_w_pw2[i], conv_b_pw2[i])
        else:
            i = layer - N_A
            q = split_heads(u @ attn_w_q[i])
            o = stick_breaking_attention(q, k_shared, v_shared)
            o = o.transpose(0, 2, 1, 3).reshape(b, s, d)
            h = h + o @ attn_w_o[i]
        h = h + HALF_STEP * swiglu_ffn(rms_norm(h, ffn2_norm[layer]),
                                       ffn2_w_gate[layer], ffn2_w_up[layer], ffn2_w_down[layer])
        if layer == N_A - 1:
            kv = rms_norm(h, kv_norm) @ w_kv
            k_flat, v_flat = jnp.split(kv, 2, axis=-1)
            k_shared = split_heads(k_flat)
            v_shared = split_heads(v_flat)
    return rms_norm(h, final_norm)
```

```cpp
#include <hip/hip_runtime.h>
#include <hip/hip_cooperative_groups.h>
#include <cstdio>
#include <cstdint>
namespace cg = cooperative_groups;
namespace pg8 {
#define PG8_LAS __attribute__((address_space(3)))
typedef unsigned short bf16_t;
typedef short bf16x8 __attribute__((ext_vector_type(8)));
typedef float f32x4 __attribute__((ext_vector_type(4)));
typedef unsigned u32x4 __attribute__((ext_vector_type(4)));
constexpr int BM = 256, BK = 64, HALF = 128, HTB = HALF * BK * 2  , STAGE_BYTES = 8 * HTB, NXCD = 8, WGM = 8;

__host__ __device__ __forceinline__ int lds_byte(int r, int c) { const int st = (r >> 4) * 2 + (c >> 5), rr = r & 15, cc = c & 31, ob = rr * 64 + cc * 2; return st * 1024 + (ob ^ (((ob >> 9) & 1) << 5)); }
__host__ __device__ __forceinline__ void stage_rc(int b, int& R, int& C) { const int st = b / 1024, sb = b % 1024, swz = sb ^ (((sb >> 9) & 1) << 5); R = (st >> 1) * 16 + swz / 64; C = (st & 1) * 32 + (swz % 64) / 2; }
__host__ __device__ __forceinline__ int perm32(int rho) { const int n = rho >> 4, i = rho & 15; return 8 * (i >> 2) + 4 * n + (i & 3); }

struct Unit { int pm, pn; };
struct Gemm { const bf16_t* A; const bf16_t* Bt; int M, N, K; };

struct StaticOrder {
    int nM, nN, nwg, G, c;
    __host__ __device__ void init(int M, int N, int G_, int c_) { nM = M / BM; nN = N / BM; nwg = nM * nN; G = G_; c = c_; }
    __host__ __device__ bool next(int i, Unit& u) const {
        const long L = (long)i * G + c; if (L >= nwg) return false;
        int wgid = (int)L; { const int q = nwg / NXCD, r = nwg % NXCD, xcd = wgid % NXCD, off = wgid / NXCD; wgid = (xcd < r ? xcd * (q + 1) : r * (q + 1) + (xcd - r) * q) + off; }
        const int nig = WGM * nN, gid = wgid / nig, fm = gid * WGM, gsz = (nM - fm) < WGM ? (nM - fm) : WGM;
        u.pm = fm + ((wgid % nig) % gsz); u.pn = (wgid % nig) / gsz; return true;
    }
    __device__ __forceinline__ void a_ready(const Unit&) const {}
    __device__ __forceinline__ void done(const Unit&) const {}
};

__device__ __forceinline__ unsigned cvt_pk_bf16(float lo, float hi) { unsigned r; asm volatile("v_cvt_pk_bf16_f32 %0, %1, %2" : "=v"(r) : "v"(lo), "v"(hi)); return r; }
typedef float f32x2 __attribute__((ext_vector_type(2)));

constexpr float RMS_EPS_F = 1e-6f, INV_D = 1.0f / 1024.0f, LOG2E = 1.4426950408889634f;
__device__ __forceinline__ float row_rstd(const float* ss, int row, int fq) { const f32x4 v = *(const f32x4*)(ss + (size_t)row * 16 + 4 * fq); float s = (v[0] + v[1]) + (v[2] + v[3]); s += __shfl_xor(s, 16); s += __shfl_xor(s, 32); return __builtin_amdgcn_rsqf(s * INV_D + RMS_EPS_F); }
__device__ __forceinline__ void row_rstd8(float (&rs)[8], const float* ss, int row0, int fq) {
    f32x4 v[8];
#pragma unroll
    for (int i = 0; i < 8; ++i) v[i] = *(const f32x4*)(ss + (size_t)(row0 + (i >> 2) * HALF + (i & 3) * 16) * 16 + 4 * fq);
#pragma unroll
    for (int i = 0; i < 8; ++i) { float s = (v[i][0] + v[i][1]) + (v[i][2] + v[i][3]); s += __shfl_xor(s, 16); s += __shfl_xor(s, 32); rs[i] = __builtin_amdgcn_rsqf(s * INV_D + RMS_EPS_F); }
}
#ifndef EPI_WT
#define EPI_WT 0
#endif
__device__ __forceinline__ void st16(bf16_t* p, u32x4 w) {
#if EPI_WT
    unsigned long long* q = (unsigned long long*)p;
    __hip_atomic_store(q, (unsigned long long)w.x | ((unsigned long long)w.y << 32), __ATOMIC_RELAXED, __HIP_MEMORY_SCOPE_AGENT);
    __hip_atomic_store(q + 1, (unsigned long long)w.z | ((unsigned long long)w.w << 32), __ATOMIC_RELAXED, __HIP_MEMORY_SCOPE_AGENT);
#else
    *(u32x4*)p = w;
#endif
}
__device__ __forceinline__ float fast_sigmoid(float g) { return __builtin_amdgcn_rcpf(1.0f + __builtin_amdgcn_exp2f(-g * LOG2E)); }

template <int MODE> struct EpiGated {
    static constexpr bool PERM = true, AFTER_DRAIN = false;
    bf16_t* O; int ldc; const float* ss; const float* b0; const float* b1;
    __device__ __forceinline__ void operator()(const f32x4 (&acc)[2][2][4][2], const Unit& u, int wr, int wc, int fr, int fq) const {
#ifdef DUP_GU
        if (ldc < 0) return;
#endif
        const int row0 = u.pm * BM + wr * 64 + fr; const int col0 = u.pn * HALF + wc * 32 + 8 * fq;
        f32x4 bv0[2], bv1[2];
#pragma unroll
        for (int n = 0; n < 2; ++n) { bv0[n] = (MODE == 1) ? *(const f32x4*)(b0 + col0 + 4 * n) : (f32x4){0.f, 0.f, 0.f, 0.f}; bv1[n] = (MODE == 1) ? *(const f32x4*)(b1 + col0 + 4 * n) : (f32x4){0.f, 0.f, 0.f, 0.f}; }
        float rs8[8]; row_rstd8(rs8, ss, row0, fq);
#pragma unroll
        for (int ai = 0; ai < 2; ++ai)
#pragma unroll
            for (int m = 0; m < 4; ++m) { const int row = row0 + ai * HALF + m * 16; const float rstd = rs8[ai * 4 + m];
                u32x4 w; unsigned wv[4];
#pragma unroll
                for (int n = 0; n < 2; ++n) { f32x4 a = acc[ai][0][m][n] * rstd + bv0[n], g = acc[ai][1][m][n] * rstd + bv1[n]; f32x4 o;
#pragma unroll
                    for (int e = 0; e < 4; ++e) { if (MODE == 0) o[e] = a[e] * fast_sigmoid(a[e]) * g[e]; else o[e] = a[e] * fast_sigmoid(g[e]); }
                    wv[2 * n] = cvt_pk_bf16(o[0], o[1]); wv[2 * n + 1] = cvt_pk_bf16(o[2], o[3]); }
                w.x = wv[0]; w.y = wv[1]; w.z = wv[2]; w.w = wv[3];
                st16(O + (size_t)row * ldc + col0, w); }
    }
};
struct EpiScaleBf16 {
    static constexpr bool PERM = true, AFTER_DRAIN = false;
    bf16_t* O; int ldc; const float* ss; int split_cols; size_t split_stride; float sc;
    __device__ __forceinline__ void operator()(const f32x4 (&acc)[2][2][4][2], const Unit& u, int wr, int wc, int fr, int fq) const {
        const int row0 = u.pm * BM + wr * 64 + fr; int colt = u.pn * BM; bf16_t* base = O;
        if (split_cols) { const int t = colt / split_cols; base += (size_t)t * split_stride; colt -= t * split_cols; }
        const int col0 = colt + wc * 32 + 8 * fq;
        float rs8[8]; row_rstd8(rs8, ss, row0, fq);
#pragma unroll
        for (int ai = 0; ai < 2; ++ai)
#pragma unroll
            for (int m = 0; m < 4; ++m) { const int row = row0 + ai * HALF + m * 16; const float rs = rs8[ai * 4 + m] * sc;
                bf16_t* rowp = base + (size_t)row * ldc + col0;
#pragma unroll
                for (int bj = 0; bj < 2; ++bj) { const f32x4 v0 = acc[ai][bj][m][0] * rs, v1 = acc[ai][bj][m][1] * rs;
                    u32x4 w; w.x = cvt_pk_bf16(v0[0], v0[1]); w.y = cvt_pk_bf16(v0[2], v0[3]); w.z = cvt_pk_bf16(v1[0], v1[1]); w.w = cvt_pk_bf16(v1[2], v1[3]);
                    st16(rowp + bj * HALF, w); } }
    }
};
__device__ __forceinline__ float bf_lo(unsigned w) { return __uint_as_float(w << 16); }
__device__ __forceinline__ float bf_hi(unsigned w) { return __uint_as_float(w & 0xffff0000u); }
struct EpiResid {
    static constexpr bool PERM = true, AFTER_DRAIN = false;
    bf16_t* hb; float* ssn; const float* bias; float alpha;
    __device__ __forceinline__ void operator()(const f32x4 (&acc)[2][2][4][2], const Unit& u, int wr, int wc, int fr, int fq) const {
#ifdef DUP_DOWN
        if (alpha == 0.0f) return;
#endif
        const int row0 = u.pm * BM + wr * 64 + fr; const int col0 = u.pn * BM + wc * 32 + 8 * fq;
        f32x4 bv[2][2];
#pragma unroll
        for (int bj = 0; bj < 2; ++bj)
#pragma unroll
            for (int n = 0; n < 2; ++n) bv[bj][n] = bias ? *(const f32x4*)(bias + col0 + bj * HALF + 4 * n) : (f32x4){0.f, 0.f, 0.f, 0.f};
        u32x4 pre[3][2];
#define RES_LOAD(it_) do { const size_t off_ = (size_t)(row0 + ((it_) >> 2) * HALF + ((it_) & 3) * 16) * 1024 + col0; \
            _Pragma("unroll") for (int bj = 0; bj < 2; ++bj) pre[(it_) % 3][bj] = *(const u32x4*)(hb + off_ + bj * HALF); } while (0)
        RES_LOAD(0); RES_LOAD(1); RES_LOAD(2);
#pragma unroll
        for (int it = 0; it < 8; ++it) { const int ai = it >> 2, m = it & 3; const int row = row0 + ai * HALF + m * 16; const size_t off = (size_t)row * 1024 + col0; float s = 0.f;
            u32x4 w[2];
#pragma unroll
            for (int bj = 0; bj < 2; ++bj) { const u32x4 hw = pre[it % 3][bj];
                const f32x4 h0 = (f32x4){bf_lo(hw.x), bf_hi(hw.x), bf_lo(hw.y), bf_hi(hw.y)}, h1 = (f32x4){bf_lo(hw.z), bf_hi(hw.z), bf_lo(hw.w), bf_hi(hw.w)};
                const f32x4 o0 = h0 + (acc[ai][bj][m][0] + bv[bj][0]) * alpha, o1 = h1 + (acc[ai][bj][m][1] + bv[bj][1]) * alpha;
                w[bj].x = cvt_pk_bf16(o0[0], o0[1]); w[bj].y = cvt_pk_bf16(o0[2], o0[3]); w[bj].z = cvt_pk_bf16(o1[0], o1[1]); w[bj].w = cvt_pk_bf16(o1[2], o1[3]);
                s += ((o0[0] * o0[0] + o0[1] * o0[1]) + (o0[2] * o0[2] + o0[3] * o0[3])) + ((o1[0] * o1[0] + o1[1] * o1[1]) + (o1[2] * o1[2] + o1[3] * o1[3])); }
            if (it + 3 < 8) RES_LOAD(it + 3);
#pragma unroll
            for (int bj = 0; bj < 2; ++bj) st16(hb + off + bj * HALF, w[bj]);
            s += __shfl_xor(s, 16); s += __shfl_xor(s, 32);
            if (fq == 0) ssn[(size_t)row * 16 + u.pn * 4 + wc] = s; }
#undef RES_LOAD
    }
};
#ifndef PG8_AUXA
#define PG8_AUXA 0
#endif
#ifndef PG8_AUXB
#define PG8_AUXB 0
#endif
template <class Epi, class Sched, bool ALIGN_EPI = false, bool SP2 = false>
__device__ __forceinline__ void gemm_phase(PG8_LAS unsigned char* lds, const Gemm g, const Sched& S, const Epi& E) {
    int tid_ = threadIdx.x; asm volatile("" : "+v"(tid_)); const int tid = tid_, wid = __builtin_amdgcn_readfirstlane(tid >> 6), lane = tid & 63, wr = wid >> 2, wc = wid & 3, fr = lane & 15, fq = lane >> 4;
    const int K = g.K, nt = K / BK;
    unsigned voffA[2], voffB[2];
#pragma unroll
    for (int i = 0; i < 2; ++i) { int R, C; stage_rc(tid * 16 + i * 8192, R, C); const int Rb = Epi::PERM ? ((R & ~31) + perm32(R & 31)) : R;
        voffA[i] = (unsigned)(R * K + C) * 2u; voffB[i] = (unsigned)(Rb * K + C) * 2u; }
    const size_t kstep = (size_t)(BK * 2);
    const size_t hstep = (size_t)HALF * K * 2;
    const size_t tstep = 2 * hstep;
    const unsigned ldsw = (unsigned)wid * 1024u;
    const int aoff = lds_byte(wr * 64 + fr, fq * 8), boff = lds_byte(wc * 32 + fr, fq * 8);
#define PG8_SA(b, h) (((b) * 2 + (h)) * HTB)
#define PG8_SB(b, h) ((4 + (b) * 2 + (h)) * HTB)
#define PG8_STAGE(bufoff, gbase, voff) do { _Pragma("unroll") for (int _i = 0; _i < 2; ++_i) \
        __builtin_amdgcn_global_load_lds((const unsigned*)((const char*)(gbase) + (voff)[_i]), (PG8_LAS unsigned*)(lds + (bufoff) + ldsw + _i * 8192), 16, 0, ((bufoff) >= 4 * HTB) ? PG8_AUXB : PG8_AUXA); } while (0)
#define PG8_LDA(dst, b, h) do { _Pragma("unroll") for (int m = 0; m < 4; ++m) _Pragma("unroll") for (int k = 0; k < 2; ++k) dst[m][k] = *(const PG8_LAS bf16x8*)(lds + PG8_SA(b, h) + aoff + m * 2048 + k * 1024); } while (0)
#define PG8_LDB(dst, b, h) do { _Pragma("unroll") for (int n = 0; n < 2; ++n) _Pragma("unroll") for (int k = 0; k < 2; ++k) dst[n][k] = *(const PG8_LAS bf16x8*)(lds + PG8_SB(b, h) + boff + n * 2048 + k * 1024); } while (0)
#define PG8_MMA(ai, bj, At, Bt) do { __builtin_amdgcn_s_setprio(1); _Pragma("unroll") for (int m = 0; m < 4; ++m) _Pragma("unroll") for (int n = 0; n < 2; ++n) _Pragma("unroll") for (int k = 0; k < 2; ++k) \
        acc[ai][bj][m][n] = __builtin_amdgcn_mfma_f32_16x16x32_bf16(Bt[n][k], At[m][k], acc[ai][bj][m][n], 0, 0, 0); __builtin_amdgcn_s_setprio(0); } while (0)
#define PG8_WAIT_V(n) asm volatile("s_waitcnt vmcnt(" #n ")" ::: "memory")
#define PG8_WAIT_L(n) asm volatile("s_waitcnt lgkmcnt(" #n ")" ::: "memory")
#define PG8_BAR __builtin_amdgcn_s_barrier()
#define PG8_SCHED __builtin_amdgcn_sched_barrier(0)
    Unit cur, nxt; int ui = 0;
    if (!S.next(0, cur)) return;
    f32x4 acc[2][2][4][2];
#pragma unroll
    for (int a = 0; a < 2; ++a)
#pragma unroll
        for (int b = 0; b < 2; ++b)
#pragma unroll
            for (int m = 0; m < 4; ++m)
#pragma unroll
                for (int n = 0; n < 2; ++n) acc[a][b][m][n] = (f32x4){0.f, 0.f, 0.f, 0.f};
    bf16x8 At[4][2], B0[2][2], B1[2][2];
    const char* cA = (const char*)g.A + (size_t)cur.pm * tstep; const char* cB = (const char*)g.Bt + (size_t)cur.pn * tstep;
    S.a_ready(cur);
    if constexpr (SP2) {
        PG8_STAGE(PG8_SB(0, 0), cB, voffB); PG8_STAGE(PG8_SB(0, 1), cB + hstep, voffB); PG8_STAGE(PG8_SA(0, 0), cA, voffA); PG8_STAGE(PG8_SA(0, 1), cA + hstep, voffA);
        if (wr == 1) PG8_BAR;
        PG8_WAIT_V(2); PG8_BAR;
        PG8_STAGE(PG8_SB(1, 0), cB + kstep, voffB); PG8_STAGE(PG8_SA(1, 0), cA + kstep, voffA); PG8_STAGE(PG8_SB(1, 1), cB + hstep + kstep, voffB);
        PG8_WAIT_V(6); PG8_BAR;
    } else {
        PG8_STAGE(PG8_SB(0, 0), cB, voffB); PG8_STAGE(PG8_SA(0, 0), cA, voffA); PG8_STAGE(PG8_SB(0, 1), cB + hstep, voffB); PG8_STAGE(PG8_SA(0, 1), cA + hstep, voffA);
        if (wr == 1) PG8_BAR;
        PG8_WAIT_V(4); PG8_BAR;
        PG8_STAGE(PG8_SB(1, 0), cB + kstep, voffB); PG8_STAGE(PG8_SA(1, 0), cA + kstep, voffA); PG8_STAGE(PG8_SB(1, 1), cB + hstep + kstep, voffB);
        PG8_WAIT_V(6); PG8_BAR;
    }
    for (;;) {
        const bool has_next = S.next(ui + 1, nxt);
        const char* nA = has_next ? (const char*)g.A + (size_t)nxt.pm * tstep : cA; const char* nB = has_next ? (const char*)g.Bt + (size_t)nxt.pn * tstep : cB;
        for (int t = 0; t < nt; t += 2) {
            const bool last = (t == nt - 2);
            const char* a1 = cA + (size_t)(t + 1) * kstep;
            const char* a2 = last ? nA : cA + (size_t)(t + 2) * kstep; const char* b2 = last ? nB : cB + (size_t)(t + 2) * kstep;
            const char* a3 = a2 + kstep; const char* b3 = b2 + kstep;
            if (last && has_next) S.a_ready(nxt);
            if constexpr (SP2) {
            PG8_LDB(B0, 0, 0); PG8_LDB(B1, 0, 1); PG8_SCHED; PG8_LDA(At, 0, 0); PG8_STAGE(PG8_SA(1, 1), a1 + hstep, voffA);
            PG8_WAIT_V(8); PG8_WAIT_L(0); PG8_BAR; PG8_MMA(0, 0, At, B0); PG8_MMA(0, 1, At, B1); PG8_BAR; PG8_SCHED;
            PG8_LDA(At, 0, 1); PG8_STAGE(PG8_SB(0, 0), b2, voffB); PG8_STAGE(PG8_SB(0, 1), b2 + hstep, voffB); PG8_STAGE(PG8_SA(0, 0), a2, voffA);
            PG8_WAIT_V(8); PG8_WAIT_L(0); PG8_BAR; PG8_MMA(1, 0, At, B0); PG8_MMA(1, 1, At, B1); PG8_BAR; PG8_SCHED;
            PG8_LDB(B0, 1, 0); PG8_LDB(B1, 1, 1); PG8_SCHED; PG8_LDA(At, 1, 0); PG8_STAGE(PG8_SA(0, 1), a2 + hstep, voffA);
            PG8_WAIT_V(8); PG8_WAIT_L(0); PG8_BAR; PG8_MMA(0, 0, At, B0); PG8_MMA(0, 1, At, B1); PG8_BAR; PG8_SCHED;
            PG8_LDA(At, 1, 1); PG8_STAGE(PG8_SB(1, 0), b3, voffB); PG8_STAGE(PG8_SB(1, 1), b3 + hstep, voffB); PG8_STAGE(PG8_SA(1, 0), a3, voffA);
            PG8_WAIT_V(8); PG8_WAIT_L(0); PG8_BAR; PG8_MMA(1, 0, At, B0); PG8_MMA(1, 1, At, B1); PG8_BAR; PG8_SCHED;
            } else {
            PG8_LDB(B0, 0, 0); PG8_SCHED; PG8_LDA(At, 0, 0); PG8_STAGE(PG8_SA(1, 1), a1 + hstep, voffA);
            PG8_WAIT_L(8); PG8_BAR; PG8_WAIT_L(0); PG8_MMA(0, 0, At, B0); PG8_BAR; PG8_SCHED;
            PG8_LDB(B1, 0, 1); PG8_STAGE(PG8_SB(0, 0), b2, voffB);
            PG8_BAR; PG8_WAIT_L(0); PG8_MMA(0, 1, At, B1); PG8_BAR;
            PG8_LDA(At, 0, 1); PG8_STAGE(PG8_SA(0, 0), a2, voffA);
            PG8_BAR; PG8_WAIT_L(0); PG8_MMA(1, 0, At, B0); PG8_BAR; PG8_SCHED;
            PG8_STAGE(PG8_SB(0, 1), b2 + hstep, voffB);
            PG8_WAIT_V(6); PG8_BAR; PG8_MMA(1, 1, At, B1); PG8_BAR;
            PG8_LDB(B0, 1, 0); PG8_SCHED; PG8_LDA(At, 1, 0); PG8_STAGE(PG8_SA(0, 1), a2 + hstep, voffA);
            PG8_WAIT_L(8); PG8_BAR; PG8_WAIT_L(0); PG8_MMA(0, 0, At, B0); PG8_BAR; PG8_SCHED;
            PG8_LDB(B1, 1, 1); PG8_STAGE(PG8_SB(1, 0), b3, voffB);
            PG8_BAR; PG8_WAIT_L(0); PG8_MMA(0, 1, At, B1); PG8_BAR;
            PG8_LDA(At, 1, 1); PG8_STAGE(PG8_SA(1, 0), a3, voffA);
            PG8_BAR; PG8_WAIT_L(0); PG8_MMA(1, 0, At, B0); PG8_BAR; PG8_SCHED;
            PG8_STAGE(PG8_SB(1, 1), b3 + hstep, voffB);
            PG8_WAIT_V(6); PG8_BAR; PG8_MMA(1, 1, At, B1); PG8_BAR;
            }
        }
        if constexpr (ALIGN_EPI) { if (wr == 0) PG8_BAR; }
        if constexpr (!Epi::AFTER_DRAIN) { E(acc, cur, wr, wc, fr, fq); S.done(cur); }
        if (!has_next) break;
#pragma unroll
        for (int a = 0; a < 2; ++a)
#pragma unroll
            for (int b = 0; b < 2; ++b)
#pragma unroll
                for (int m = 0; m < 4; ++m)
#pragma unroll
                    for (int n = 0; n < 2; ++n) acc[a][b][m][n] = (f32x4){0.f, 0.f, 0.f, 0.f};
        cur = nxt; cA = nA; cB = nB; ++ui;
        if constexpr (ALIGN_EPI) { if (wr == 1) PG8_BAR; }
    }
    PG8_WAIT_V(0);
    if constexpr (!ALIGN_EPI) { if (wr == 0) PG8_BAR; }
    PG8_BAR;
    if constexpr (Epi::AFTER_DRAIN) { E.fused(acc, cur, wr, wc, fr, fq, lds, wid, lane); S.done(cur); }
#undef PG8_SA
#undef PG8_SB
#undef PG8_STAGE
#undef PG8_LDA
#undef PG8_LDB
#undef PG8_MMA
#undef PG8_WAIT_V
#undef PG8_WAIT_L
#undef PG8_BAR
#undef PG8_SCHED
}
}

constexpr int NWAVES = 8, NTHR = 512;
constexpr int BATCH = 8, SEQ = 2048, D = 1024, FF = 2816, NH = 16, HD = 64, CW = 31;
constexpr int M = BATCH * SEQ;
constexpr size_t MiB = 1u << 20;
constexpr size_t WS_SS = 344 * MiB;
constexpr size_t WS_HB = 2 * MiB;
constexpr size_t WS_K = 34 * MiB, WS_V = 66 * MiB;
constexpr size_t WS_ACT = 98 * MiB;
constexpr size_t WS_W = 186 * MiB;
constexpr size_t W_FFN_STRIDE = 16 * MiB + MiB / 2, W_FFN_DOWN = 11 * MiB;
constexpr size_t WS_WX = WS_W + 8 * W_FFN_STRIDE;
constexpr size_t WS_END = WS_SS + 13 * MiB;
constexpr int SSM = M * 16;
constexpr int NSS = 13;
constexpr int LDS_BYTES = 147456;

#define GAS __attribute__((address_space(1)))
#define LAS __attribute__((address_space(3)))
typedef unsigned short bf16;
typedef unsigned v4u __attribute__((ext_vector_type(4)));
typedef float f32x4 __attribute__((ext_vector_type(4)));
typedef float f32x2 __attribute__((ext_vector_type(2)));
typedef short bf16x8 __attribute__((ext_vector_type(8)));
#define LDS_WAIT() asm volatile("s_waitcnt lgkmcnt(0)" ::: "memory")
#define VM_WAIT() asm volatile("s_waitcnt vmcnt(0)" ::: "memory")
typedef __bf16 bf16x2_t __attribute__((ext_vector_type(2)));
__device__ __forceinline__ unsigned pk2(float lo, float hi) { f32x2 v = {lo, hi}; bf16x2_t b = __builtin_convertvector(v, bf16x2_t); return __builtin_bit_cast(unsigned, b); }
__device__ __forceinline__ float wave_sum(float v) {
#pragma unroll
    for (int o = 1; o < 64; o <<= 1) v += __shfl_xor(v, o);
    return v;
}

struct Args { const float* in[23]; float* out; unsigned char* ws; };
enum { I_X = 0, I_F1N, I_F1G, I_F1U, I_F1D, I_MIXN, I_F2N, I_F2G, I_F2U, I_F2D, I_PW1, I_BPW1, I_WDW, I_BDW, I_LNG, I_LNB, I_PW2, I_BPW2, I_KVN, I_WKV, I_WQ, I_WO, I_FINN };

__device__ __forceinline__ void xpose_item(const float* W, int K, int N, const float* gain, bf16* WT, int mode, LAS float* scr, int item, int lane) {
    const int nblk = N / 64, kb = item / nblk, nb = item % nblk, k0 = 64 * kb, n0 = 64 * nb;
    int d0 = n0;
    if (mode == 1) d0 = 256 * (n0 >> 7) + (n0 & 127);
    else if (mode == 2) d0 = 256 * (n0 >> 7) + 128 + (n0 & 127);
    else if (mode == 3) { const int nn = n0 & 1023; d0 = 256 * (nn >> 7) + 128 * (n0 >> 10) + (nn & 127); }
    const float* src = W + (size_t)k0 * N + n0 + lane;
    float v[64];
#pragma unroll
    for (int i = 0; i < 64; ++i) v[i] = src[(size_t)i * N];
    if (gain) {
#pragma unroll
        for (int i = 0; i < 64; ++i) v[i] *= gain[k0 + i];
    }
#pragma unroll
    for (int i = 0; i < 64; ++i) scr[i * 65 + lane] = v[i];
    LDS_WAIT(); asm volatile("" ::: "memory");
    const int c = lane & 7;
#pragma unroll
    for (int j = 0; j < 8; ++j) { const int n = (lane >> 3) + 8 * j; const LAS float* s = scr + (8 * c) * 65 + n;
        v4u o; o.x = pk2(s[0 * 65], s[1 * 65]); o.y = pk2(s[2 * 65], s[3 * 65]); o.z = pk2(s[4 * 65], s[5 * 65]); o.w = pk2(s[6 * 65], s[7 * 65]);
        *(GAS v4u*)(WT + (size_t)(d0 + n) * K + k0 + 8 * c) = o; }
    LDS_WAIT(); asm volatile("" ::: "memory");
}

__device__ __forceinline__ void convert_ffn(const Args& a, int f, LAS unsigned char* lds, int iw, int nw, int wave, int lane_) {
    int lane = lane_; asm volatile("" : "+v"(lane));
    LAS float* scr = (LAS float*)(lds + wave * 16640);
    const int l = f >> 1, which = f & 1; unsigned char* ws = a.ws;
    bf16* wb = (bf16*)(ws + WS_W + (size_t)f * W_FFN_STRIDE);
    const float* gain = a.in[which ? I_F2N : I_F1N] + l * D;
    for (int it = iw; it < 3 * 704; it += nw) {
        const int kind = it / 704, r = it - kind * 704;
        if (kind == 0) xpose_item(a.in[which ? I_F2G : I_F1G] + (size_t)l * D * FF, D, FF, gain, wb, 1, scr, r, lane);
        else if (kind == 1) xpose_item(a.in[which ? I_F2U : I_F1U] + (size_t)l * D * FF, D, FF, gain, wb, 2, scr, r, lane);
        else xpose_item(a.in[which ? I_F2D : I_F1D] + (size_t)l * D * FF, FF, D, nullptr, (bf16*)(ws + WS_W + (size_t)f * W_FFN_STRIDE + W_FFN_DOWN), 0, scr, r, lane);
    }
}
__device__ __forceinline__ void convert_small(const Args& a, int grp, LAS unsigned char* lds, int iw, int nw, int wave, int lane_) {
    int lane = lane_; asm volatile("" : "+v"(lane));
    LAS float* scr = (LAS float*)(lds + wave * 16640); unsigned char* ws = a.ws;
    for (int it = iw; it < 768; it += nw) {
        if (grp < 2) {
            if (it < 512) xpose_item(a.in[I_PW1] + (size_t)grp * D * 2 * D, D, 2 * D, a.in[I_MIXN] + grp * D, (bf16*)(ws + WS_WX + (size_t)grp * 4 * MiB), 3, scr, it, lane);
            else xpose_item(a.in[I_PW2] + (size_t)grp * D * D, D, D, nullptr, (bf16*)(ws + WS_WX + (12 + 2 * grp) * MiB), 0, scr, it - 512, lane);
        } else if (grp == 2) {
            if (it < 512) xpose_item(a.in[I_WKV], D, 2 * D, a.in[I_KVN], (bf16*)(ws + WS_WX + 8 * MiB), 0, scr, it, lane);
            else xpose_item(a.in[I_WQ], D, D, a.in[I_MIXN] + 2 * D, (bf16*)(ws + WS_WX + 16 * MiB), 0, scr, it - 512, lane);
        } else {
            if (it < 256) xpose_item(a.in[I_WO], D, D, nullptr, (bf16*)(ws + WS_WX + 20 * MiB), 0, scr, it, lane);
            else if (it < 512) xpose_item(a.in[I_WQ] + (size_t)D * D, D, D, a.in[I_MIXN] + 3 * D, (bf16*)(ws + WS_WX + 18 * MiB), 0, scr, it - 256, lane);
            else xpose_item(a.in[I_WO] + (size_t)D * D, D, D, nullptr, (bf16*)(ws + WS_WX + 22 * MiB), 0, scr, it - 512, lane);
        }
    }
}
__device__ __forceinline__ void prologue_phase(const Args& a, LAS unsigned char* lds, int vcu, int G, int wave, int lane) {
    LAS float* scr = (LAS float*)(lds + wave * 16640);
    const int gw = vcu * NWAVES + wave, NGW = G * NWAVES;
    unsigned char* ws = a.ws;
    convert_ffn(a, 0, lds, gw, NGW, wave, lane);
    float* ss = (float*)(ws + WS_SS); bf16* hb = (bf16*)(ws + WS_HB);
    const int rstart = (G == 256) ? (vcu >> 5) * (M / 8) + (vcu & 31) * NWAVES + wave : gw, rstep = (G == 256) ? 256 : NGW, rend = (G == 256) ? ((vcu >> 5) + 1) * (M / 8) : M;
    for (int m0 = rstart; m0 < rend; m0 += 4 * rstep) {
        f32x4 v[4][4];
#pragma unroll
        for (int q = 0; q < 4; ++q) { const int m = m0 + q * rstep; if (m < rend) { const GAS f32x4* xr = (const GAS f32x4*)(a.in[I_X] + (size_t)m * D) + lane;
#pragma unroll
            for (int j = 0; j < 4; ++j) v[q][j] = xr[64 * j]; } }
#pragma unroll
        for (int q = 0; q < 4; ++q) { const int m = m0 + q * rstep; if (m < rend) { float s = 0.f;
#pragma unroll
            for (int j = 0; j < 4; ++j) s += (v[q][j].x * v[q][j].x + v[q][j].y * v[q][j].y) + (v[q][j].z * v[q][j].z + v[q][j].w * v[q][j].w);
            s = wave_sum(s); if (lane < 16) ss[(size_t)m * 16 + lane] = (lane == 0) ? s : 0.f;
            GAS unsigned long long* o8 = (GAS unsigned long long*)(hb + (size_t)m * D) + lane;
#pragma unroll
            for (int j = 0; j < 4; ++j) o8[64 * j] = (unsigned long long)pk2(v[q][j].x, v[q][j].y) | ((unsigned long long)pk2(v[q][j].z, v[q][j].w) << 32); } }
    }
}

__device__ __forceinline__ void final_phase(float* out, const bf16* hb, const float* ss, const float* g, int vcu, int G, int wave, int lane) {
    const int gw = vcu * NWAVES + wave, NGW = G * NWAVES;
    f32x4 gv[2][2];
#pragma unroll
    for (int j = 0; j < 2; ++j) { gv[j][0] = *(const f32x4*)(g + 512 * j + 8 * lane); gv[j][1] = *(const f32x4*)(g + 512 * j + 8 * lane + 4); }
    const int rstart = (G == 256) ? (vcu >> 5) * (M / 8) + (vcu & 31) * NWAVES + wave : gw, rstep = (G == 256) ? 256 : NGW, rend = (G == 256) ? ((vcu >> 5) + 1) * (M / 8) : M;
    for (int m0 = rstart; m0 < rend; m0 += 4 * rstep) {
        float sq[4]; v4u hw[4][2];
#pragma unroll
        for (int q = 0; q < 4; ++q) { const int m = m0 + q * rstep; if (m < rend) { sq[q] = ss[(size_t)m * 16 + (lane & 15)];
#pragma unroll
            for (int j = 0; j < 2; ++j) hw[q][j] = *(const GAS v4u*)(hb + (size_t)m * D + 512 * j + 8 * lane); } }
#pragma unroll
        for (int q = 0; q < 4; ++q) { const int m = m0 + q * rstep; if (m < rend) { float t = sq[q]; t += __shfl_xor(t, 1); t += __shfl_xor(t, 2); t += __shfl_xor(t, 4); t += __shfl_xor(t, 8); const float rstd = __builtin_amdgcn_rsqf(t * (1.0f / D) + 1e-6f);
#pragma unroll
            for (int j = 0; j < 2; ++j) { const v4u w = hw[q][j];
                const f32x4 h0 = (f32x4){pg8::bf_lo(w.x), pg8::bf_hi(w.x), pg8::bf_lo(w.y), pg8::bf_hi(w.y)}, h1 = (f32x4){pg8::bf_lo(w.z), pg8::bf_hi(w.z), pg8::bf_lo(w.w), pg8::bf_hi(w.w)};
                GAS f32x4* o = (GAS f32x4*)(out + (size_t)m * D + 512 * j + 8 * lane); o[0] = h0 * rstd * gv[j][0]; o[1] = h1 * rstd * gv[j][1]; } } }
    }
}

__device__ __forceinline__ void dwconv_phase(const bf16* glu, bf16* cv, const float* wdw, const float* bdw, const float* lng, const float* lnb, LAS unsigned char* lds, int vcu, int G) {
    constexpr int TT = 16, NIN = TT + CW - 1, RS = 520;
    int tid_ = threadIdx.x; asm volatile("" : "+v"(tid_)); const int tid = tid_, c = 2 * tid;
    f32x2 w[CW];
#pragma unroll
    for (int j = 0; j < CW; ++j) w[j] = *(const f32x2*)(wdw + j * D + c);
    const f32x2 bd = *(const f32x2*)(bdw + c), gg = *(const f32x2*)(lng + c), bb = *(const f32x2*)(lnb + c);
    LAS float* red = (LAS float*)lds; LAS float* fin = (LAS float*)(lds + 2 * TT * RS * 4);
    const int ntile = M / TT, tstart = (G == 256) ? (vcu >> 5) * (ntile / 8) + (vcu & 31) : vcu, tstep = (G == 256) ? 32 : G, tend = (G == 256) ? ((vcu >> 5) + 1) * (ntile / 8) : ntile;
    for (int tile = tstart; tile < tend; tile += tstep) {
        const int m0 = tile * TT, t0 = m0 & (SEQ - 1);
        unsigned in[NIN];
#pragma unroll
        for (int i = 0; i < NIN; ++i) { in[i] = 0u; if (t0 - (CW - 1) + i >= 0) in[i] = *(const unsigned*)(glu + (size_t)(m0 - (CW - 1) + i) * D + c); }
        f32x2 o[TT];
#pragma unroll
        for (int t = 0; t < TT; ++t) o[t] = bd;
#pragma unroll
        for (int i = 0; i < NIN; ++i) { f32x2 x; x.x = __uint_as_float(in[i] << 16); x.y = __uint_as_float(in[i] & 0xffff0000u);
#pragma unroll
            for (int t = 0; t < TT; ++t) { const int j = i - t; if (j >= 0 && j < CW) o[t] += w[j] * x; } }
#pragma unroll
        for (int t = 0; t < TT; ++t) { red[(2 * t) * RS + tid] = o[t].x + o[t].y; red[(2 * t + 1) * RS + tid] = o[t].x * o[t].x + o[t].y * o[t].y; }
        __syncthreads();
        { const int v = tid >> 4, j = tid & 15; float s = 0.f;
#pragma unroll
          for (int i = 0; i < 32; ++i) s += red[v * RS + j + 16 * i];
          s += __shfl_xor(s, 8); s += __shfl_xor(s, 4); s += __shfl_xor(s, 2); s += __shfl_xor(s, 1);
          if (j == 0) fin[v] = s; }
        __syncthreads();
#pragma unroll
        for (int t = 0; t < TT; ++t) { const float mean = fin[2 * t] * (1.0f / D), var = fin[2 * t + 1] * (1.0f / D) - mean * mean, rstd = __builtin_amdgcn_rsqf(var + 1e-5f);
            f32x2 y = (o[t] - mean) * rstd * gg + bb; y.x = y.x * pg8::fast_sigmoid(y.x); y.y = y.y * pg8::fast_sigmoid(y.y);
            *(unsigned*)(cv + (size_t)(m0 + t) * D + c) = pk2(y.x, y.y); }
    }
    __syncthreads();
}

namespace sba {
typedef short s16x4 __attribute__((ext_vector_type(4)));
typedef float f32x16 __attribute__((ext_vector_type(16)));
typedef short v4i16_t __attribute__((ext_vector_type(4)));
typedef LAS const char* lds_cptr;
__device__ __forceinline__ int crow(int r, int hi) { return (r & 3) + 8 * (r >> 2) + 4 * hi; }
__device__ __forceinline__ s16x4 vtr(lds_cptr p) { return __builtin_bit_cast(s16x4, __builtin_amdgcn_ds_read_tr16_b64_v4i16((LAS v4i16_t*)p)); }

constexpr float FSTOP = 3.5527136788e-15f;
__device__ __forceinline__ void attn_item4(int b, int h, int qblk, const bf16* Q, const bf16* __restrict__ K, const bf16* __restrict__ V, bf16* O, LAS unsigned char* wl  , int lane) {
    const int r32 = lane & 31, hi = lane >> 5;
    const long rowbase = (long)b * SEQ; const int t0 = qblk * 32;
    const bf16* Qw = Q + (rowbase + t0) * D + h * HD;
    const bf16* kg = K + rowbase * D + h * HD + (long)r32 * D + hi * 8;
    const bf16* vsrc = V + rowbase * D + h * HD + (long)(lane >> 2) * D + (lane & 3) * 8;
#define SB_KLD(dst_, j_) do { _Pragma("unroll") for (int d0_ = 0; d0_ < 4; ++d0_) dst_[d0_] = *(const bf16x8*)(kg + (long)(j_) * 32 * D + d0_ * 16); } while (0)
#define SB_VDMA(j_, slot_) do { _Pragma("unroll") for (int c_ = 0; c_ < 4; ++c_) \
        __builtin_amdgcn_global_load_lds((const unsigned*)(vsrc + (long)((j_) * 32 + 16 * (c_ & 1)) * D + (c_ >> 1) * 32), (LAS unsigned*)(wl + (slot_) * 4096 + c_ * 1024), 16, 0, 0); } while (0)
    const lds_cptr vp0 = (lds_cptr)wl + ((lane >> 4) & 1) * 32 + (lane & 3) * 8 + (4 * hi + ((lane & 15) >> 2)) * 64;
    const int j0 = qblk;
    bf16x8 k0[4], k1[4], k2[4], qr[4];
#pragma unroll
    for (int d0 = 0; d0 < 4; ++d0) { k1[d0] = bf16x8{}; k2[d0] = bf16x8{}; }
    SB_KLD(k0, j0); SB_VDMA(j0, 0);
#pragma unroll
    for (int d0 = 0; d0 < 4; ++d0) qr[d0] = *(const bf16x8*)(Qw + (long)r32 * D + d0 * 16 + hi * 8);
    if (j0 >= 1) { SB_KLD(k1, j0 - 1); SB_VDMA(j0 - 1, 1); }
    if (j0 >= 2) { SB_KLD(k2, j0 - 2); SB_VDMA(j0 - 2, 2); }
    f32x16 o[2]; o[0] = f32x16{}; o[1] = f32x16{};
    float F = 1.0f;
    const int qpos = t0 + r32;
    for (int j = j0; j >= 0; --j) {
        const int slot = (j0 - j) & 3;
        if (j >= 2) asm volatile("s_waitcnt vmcnt(16)" ::: "memory"); else if (j == 1) asm volatile("s_waitcnt vmcnt(8)" ::: "memory"); else asm volatile("s_waitcnt vmcnt(0)" ::: "memory");
        f32x16 p = __builtin_amdgcn_mfma_f32_32x32x16_bf16(k0[0], qr[0], f32x16{}, 0, 0, 0);
#pragma unroll
        for (int d0 = 1; d0 < 4; ++d0) p = __builtin_amdgcn_mfma_f32_32x32x16_bf16(k0[d0], qr[d0], p, 0, 0, 0);
        const bool diag = (j == j0);
        float beta[16], om[16];
#pragma unroll
        for (int r = 0; r < 16; ++r) { const float e = __builtin_amdgcn_exp2f(-p[r]); float bt = __builtin_amdgcn_rcpf(1.0f + e); float m1 = 1.0f - bt;
            if (diag) { const int kv = 32 * j + crow(r, hi); if (kv >= qpos) { bt = 0.f; m1 = 1.f; } }
            beta[r] = bt; om[r] = m1; }
        float A1[4], A0[4], T[4], PT[4];
#pragma unroll
        for (int g = 0; g < 4; ++g) { A1[g] = om[4 * g + 3] * om[4 * g + 2]; A0[g] = A1[g] * om[4 * g + 1]; T[g] = A0[g] * om[4 * g]; }
#pragma unroll
        for (int g = 0; g < 4; ++g) PT[g] = __shfl_xor(T[g], 32);
        float X = 1.f, carry[4];
#pragma unroll
        for (int g = 3; g >= 0; --g) { carry[g] = F * X * (hi == 0 ? PT[g] : 1.f); X *= T[g] * PT[g]; }
        F *= X;
        unsigned pw[2][4];
#pragma unroll
        for (int g = 0; g < 4; ++g) { const float w3 = beta[4 * g + 3] * carry[g], w2 = beta[4 * g + 2] * (carry[g] * om[4 * g + 3]), w1 = beta[4 * g + 1] * (carry[g] * A1[g]), w0 = beta[4 * g] * (carry[g] * A0[g]);
            pw[g >> 1][(g & 1) * 2] = pk2(w0, w1); pw[g >> 1][(g & 1) * 2 + 1] = pk2(w2, w3); }
        const lds_cptr vp = vp0 + slot * 4096;
#pragma unroll
        for (int d0 = 0; d0 < 2; ++d0)
#pragma unroll
            for (int ks = 0; ks < 2; ++ks) { const s16x4 lo = vtr(vp + d0 * 2048 + ks * 1024), hh = vtr(vp + d0 * 2048 + ks * 1024 + 512);
                const bf16x8 vf = (bf16x8){lo[0], lo[1], lo[2], lo[3], hh[0], hh[1], hh[2], hh[3]};
                const v4u pa = (v4u){pw[ks][0], pw[ks][1], pw[ks][2], pw[ks][3]};
                o[d0] = __builtin_amdgcn_mfma_f32_32x32x16_bf16(__builtin_bit_cast(bf16x8, pa), vf, o[d0], 0, 0, 0); }
        if (__all(F < FSTOP)) break;
        LDS_WAIT();
#pragma unroll
        for (int d0 = 0; d0 < 4; ++d0) { k0[d0] = k1[d0]; k1[d0] = k2[d0]; }
        if (j >= 3) { SB_KLD(k2, j - 3); SB_VDMA(j - 3, (slot + 3) & 3); }
    }
    VM_WAIT(); LDS_WAIT();
    { LAS bf16* stg = (LAS bf16*)wl;
      bf16* Ow = O + (rowbase + t0) * D + h * HD;
#pragma unroll
      for (int r = 0; r < 16; ++r) { const int orow = crow(r, hi);
#pragma unroll
          for (int d0 = 0; d0 < 2; ++d0) stg[orow * 64 + d0 * 32 + r32] = (bf16)(pk2(o[d0][r], 0.f) & 0xffffu); }
      LDS_WAIT();
#pragma unroll
      for (int i = 0; i < 4; ++i) { const int row = i * 8 + (lane >> 3), ch = lane & 7; const v4u v = *(const LAS v4u*)(stg + row * 64 + ch * 8); *(v4u*)(Ow + (long)row * D + ch * 8) = v; } }
    LDS_WAIT();
#undef SB_KLD
#undef SB_VDMA
}
__device__ __forceinline__ unsigned attn_pull(unsigned* ctr, int lane) { unsigned v = 0u; if (lane == 0) v = __hip_atomic_fetch_add(ctr, 1u, __ATOMIC_RELAXED, __HIP_MEMORY_SCOPE_AGENT); return (unsigned)__builtin_amdgcn_readfirstlane((int)v); }
__device__ __forceinline__ void attn_phase_q(const bf16* Q, const bf16* K, const bf16* V, bf16* O, LAS unsigned char* lds, int vcu, int G, unsigned* ctr) {
    int tid_ = threadIdx.x; asm volatile("" : "+v"(tid_)); const int lane = tid_ & 63, wid = __builtin_amdgcn_readfirstlane(tid_ >> 6);
    LAS unsigned char* wl = lds + wid * 16384;
    const int home = (G == 256) ? (vcu >> 5) : (vcu & 7);
    for (int gi = 0; gi < BATCH; ++gi) {
        const int grp = (home + gi) & 7; unsigned* c = ctr + 64 * grp;
        unsigned nxt = attn_pull(c, lane);
        while (nxt < (unsigned)(NH * (SEQ / 32))) { const unsigned cur = nxt; nxt = attn_pull(c, lane);
            attn_item4(grp, (int)(cur & 15u), 63 - (int)(cur >> 4), Q, K, V, O, wl, lane); }
    }
    __syncthreads();
}
__device__ __forceinline__ void attn_phase_v4(const bf16* Q, const bf16* K, const bf16* V, bf16* O, LAS unsigned char* lds, int vcu, int G) {
    int tid_ = threadIdx.x; asm volatile("" : "+v"(tid_)); const int lane = tid_ & 63, wid = __builtin_amdgcn_readfirstlane(tid_ >> 6);
    LAS unsigned char* wl = lds + wid * 16384;
    if (G == 256) {
        const int xb = vcu >> 5, lw = (vcu & 31) * NWAVES + wid;
        for (int i = 0; i < 4; ++i) { const int v = lw + 256 * i; attn_item4(xb, v & 15, 63 - (v >> 4), Q, K, V, O, wl, lane); }
    } else {
        const int NITEM = BATCH * NH * (SEQ / 32);
        for (int u = vcu * NWAVES + wid; u < NITEM; u += G * NWAVES) { const int bh = u & 127, qblk = 63 - (u >> 7); attn_item4(bh / NH, bh % NH, qblk, Q, K, V, O, wl, lane); }
    }
    __syncthreads();
}
}

#define XB_TMO      128
#define XB_XCNT(j)  (256  + 64 * (j))
#define XB_XSUB(j)  (1280 + 64 * (j))
#define XB_XGEN(j)  (2304 + 64 * (j))
#define XB_TOP      3328
#define XB_TOPGEN   3392
#define XCD_BAR_WORDS 3456
#define XB_SPIN_CAP (1u << 18)

__device__ __forceinline__ unsigned xb_ld(unsigned* p)              { return __hip_atomic_load(p, __ATOMIC_RELAXED, __HIP_MEMORY_SCOPE_AGENT); }
__device__ __forceinline__ unsigned xb_add(unsigned* p, unsigned v) { return __hip_atomic_fetch_add(p, v, __ATOMIC_RELAXED, __HIP_MEMORY_SCOPE_AGENT); }
__device__ __forceinline__ unsigned xb_xcc_id() { return (unsigned)__builtin_amdgcn_s_getreg((3 << 11) | 20) & 0xFu; }
#define XB_SPIN(cond, bar) do { unsigned _sp = 0; while (cond) { __builtin_amdgcn_s_sleep(1); \
    if ((++_sp & 255u) == 0u) { if (xb_ld(&(bar)[XB_TMO])) break; if (_sp > XB_SPIN_CAP) { atomicAdd(&(bar)[XB_TMO], 1u); break; } } } } while (0)

struct XcdBarrier {
    unsigned* bar; unsigned x;
    volatile LAS unsigned* st;
};

__device__ __forceinline__ XcdBarrier xcd_barrier_post(unsigned* bar, volatile LAS unsigned* st) {
    XcdBarrier b; b.bar = bar; b.x = xb_xcc_id(); b.st = st;
    if (threadIdx.x == 0) (void)xb_add(&bar[XB_XCNT(b.x)], 1u);
    return b;
}
__device__ __forceinline__ void xcd_barrier_complete(unsigned* bar, unsigned x, unsigned& nloc, unsigned& nx) {
    const unsigned G = gridDim.x * gridDim.y * gridDim.z;
    unsigned sum, cnt, mine, sp = 0u;
    for (;;) {
        sum = 0u; cnt = 0u; mine = 0u;
#pragma unroll
        for (unsigned j = 0; j < 16; ++j) { const unsigned c = xb_ld(&bar[XB_XCNT(j)]); sum += c; cnt += (c > 0u) ? 1u : 0u; mine = (j == x) ? c : mine; }
        if (sum == G) break;
        __builtin_amdgcn_s_sleep(1);
        if ((++sp & 255u) == 0u) { if (xb_ld(&bar[XB_TMO])) break; if (sp > XB_SPIN_CAP) { atomicAdd(&bar[XB_TMO], 1u); break; } }
    }
    nloc = mine > 0u ? mine : 1u; nx = cnt > 0u ? cnt : 1u;
}

__device__ __forceinline__ void xcd_barrier(const XcdBarrier& b) {
    asm volatile("s_waitcnt vmcnt(0)" ::: "memory");
    __syncthreads();
    if (threadIdx.x == 0) {
        unsigned* bar = b.bar;
        __builtin_amdgcn_s_waitcnt(0);
        unsigned nloc = b.st[0], nx = b.st[1];
        if (nloc == 0u) { xcd_barrier_complete(bar, b.x, nloc, nx); b.st[0] = nloc; b.st[1] = nx; }
        const unsigned old = xb_add(&bar[XB_XSUB(b.x)], 1u);
        const unsigned gen = old / nloc;
        if (old + 1u == (gen + 1u) * nloc) {
            __builtin_amdgcn_fence(__ATOMIC_RELEASE, "agent");
            asm volatile("s_waitcnt vmcnt(0)" ::: "memory");
            const unsigned og = xb_add(&bar[XB_TOP], 1u);
            const unsigned tg = og / nx;
            if (og + 1u == (tg + 1u) * nx) xb_add(&bar[XB_TOPGEN], 1u);
            else XB_SPIN(xb_ld(&bar[XB_TOPGEN]) == tg, bar);
            __builtin_amdgcn_fence(__ATOMIC_ACQUIRE, "agent");
            xb_add(&bar[XB_XGEN(b.x)], 1u);
            asm volatile("s_waitcnt vmcnt(0)" ::: "memory");
        } else {
            XB_SPIN(xb_ld(&bar[XB_XGEN(b.x)]) == gen, bar);
            __builtin_amdgcn_fence(__ATOMIC_ACQUIRE, "agent");
            asm volatile("s_waitcnt vmcnt(0)" ::: "memory");
        }
    }
    __syncthreads();
}

__global__ void __launch_bounds__(NTHR, 2) mk_fwd(Args a) {
    extern __shared__ __attribute__((aligned(16))) unsigned char lds_raw[];
    cg::grid_group grid = cg::this_grid();
    LAS unsigned char* lds = (LAS unsigned char*)lds_raw;
    const int tid = threadIdx.x, lane = tid & 63, wave = __builtin_amdgcn_readfirstlane(tid >> 6);
    const int G = gridDim.x, bx = blockIdx.x; const int vcu = (G % 8 == 0) ? (bx % 8) * (G / 8) + bx / 8 : bx;
    unsigned char* ws = a.ws;
    float* ss = (float*)(ws + WS_SS); bf16* hb = (bf16*)(ws + WS_HB); bf16* KB = (bf16*)(ws + WS_K); bf16* VB = (bf16*)(ws + WS_V);
    bf16* ACT = (bf16*)(ws + WS_ACT); bf16* B0 = ACT; bf16* B1 = (bf16*)(ws + WS_ACT + 32 * MiB);
    float* h = a.out;
    volatile LAS unsigned* xst = (volatile LAS unsigned*)(lds + LDS_BYTES - 64);
    if (tid < 4) xst[tid] = 0u;
    __syncthreads();
    XcdBarrier xbar = xcd_barrier_post((unsigned*)ws, xst);

#ifndef DBG_STOP
#define DBG_STOP 0
#endif
#ifndef DBG_SRC
#define DBG_SRC 5
#endif
    int nsync = 0;
#ifdef DUP_SYNC
#define DUP_SYNC_BODY xcd_barrier(xbar);
#else
#define DUP_SYNC_BODY
#endif
#define GRID_SYNC() do { xcd_barrier(xbar); \
        DUP_SYNC_BODY \
        if (DBG_STOP && ++nsync == DBG_STOP) { const bf16* src_ = DBG_SRC == 0 ? hb : DBG_SRC == 1 ? B0 : DBG_SRC == 2 ? B1 : DBG_SRC == 3 ? KB : VB; \
            for (size_t i_ = (size_t)bx * NTHR + tid; i_ < (size_t)M * D; i_ += (size_t)G * NTHR) { float v_ = __uint_as_float((unsigned)((DBG_SRC == 5) ? hb[i_] : src_[i_]) << 16); if (!(__builtin_fabsf(v_) < 1e30f)) v_ = 12345.0f; h[i_] = v_; } return; } } while (0)
#ifdef DUP_PRO
    prologue_phase(a, lds, vcu, G, wave, lane); __syncthreads();
#endif
    prologue_phase(a, lds, vcu, G, wave, lane);
    GRID_SYNC();

#ifndef GEMM_SP2
#define GEMM_SP2 true
#endif
#ifndef GEMM_ALIGN
#define GEMM_ALIGN true
#endif
#define GEMM(EpiT, Aptr, Bptr, N_, K_, epi) do { pg8::Gemm g_{(const bf16*)(Aptr), (const bf16*)(Bptr), M, (N_), (K_)}; pg8::StaticOrder S_; S_.init(M, (N_), G, bx); \
        pg8::gemm_phase<EpiT, pg8::StaticOrder, GEMM_ALIGN, GEMM_SP2>(lds, g_, S_, epi); } while (0)

    for (int l = 0; l < 4; ++l) {
        for (int which = 0; which < 2; ++which) {
            const int f = 2 * l + which;
            if (which == 1) {
                if (l < 2) {
                    { pg8::EpiGated<1> E{B0, D, ss + (3 * l + 1) * SSM, a.in[I_BPW1] + l * 2 * D, a.in[I_BPW1] + l * 2 * D + D}; GEMM(pg8::EpiGated<1>, hb, ws + WS_WX + (size_t)l * 4 * MiB, 2 * D, D, E); }
                    GRID_SYNC();
#ifdef DUP_DW
                    dwconv_phase(B0, B1, a.in[I_WDW] + l * CW * D, a.in[I_BDW] + l * D, a.in[I_LNG] + l * D, a.in[I_LNB] + l * D, lds, vcu, G);
#endif
                    dwconv_phase(B0, B1, a.in[I_WDW] + l * CW * D, a.in[I_BDW] + l * D, a.in[I_LNG] + l * D, a.in[I_LNB] + l * D, lds, vcu, G);
                    GRID_SYNC();
                    { pg8::EpiResid E{hb, ss + (3 * l + 2) * SSM, a.in[I_BPW2] + l * D, 1.0f}; GEMM(pg8::EpiResid, B1, ws + WS_WX + (12 + 2 * l) * MiB, D, D, E); }
                    GRID_SYNC();
                } else {
                    const int i = l - 2;
                    { pg8::EpiScaleBf16 E{B0, D, ss + (3 * l + 1) * SSM, 0, 0, 0.125f * pg8::LOG2E}; GEMM(pg8::EpiScaleBf16, hb, ws + WS_WX + (16 + 2 * i) * MiB, D, D, E); }
                    GRID_SYNC();
#ifdef DUP_ATT
                    sba::attn_phase_q(B0, KB, VB, B1, lds, vcu, G, (unsigned*)ws + 3584 + 512 * i);
#endif
                    sba::attn_phase_q(B0, KB, VB, B1, lds, vcu, G, (unsigned*)ws + 3584 + 512 * i);
                    GRID_SYNC();
                    { pg8::EpiResid E{hb, ss + (3 * l + 2) * SSM, nullptr, 1.0f}; GEMM(pg8::EpiResid, B1, ws + WS_WX + (20 + 2 * i) * MiB, D, D, E); }
                    GRID_SYNC();
                }
            }
            const int si = 3 * l + (which ? 2 : 0);
#ifdef DUP_GU
            { pg8::EpiGated<0> E{ACT, (a.ws != nullptr) ? -FF : FF, ss + si * SSM, nullptr, nullptr}; GEMM(pg8::EpiGated<0>, hb, ws + WS_W + (size_t)f * W_FFN_STRIDE, 2 * FF, D, E); }
#endif
            { pg8::EpiGated<0> E{ACT, FF, ss + si * SSM, nullptr, nullptr}; GEMM(pg8::EpiGated<0>, hb, ws + WS_W + (size_t)f * W_FFN_STRIDE, 2 * FF, D, E); }
            if (l == 2 && which == 0) {
                pg8::EpiScaleBf16 E{KB, D, ss + si * SSM, D, (size_t)(WS_V - WS_K) / 2, 1.0f}; GEMM(pg8::EpiScaleBf16, hb, ws + WS_WX + 8 * MiB, 2 * D, D, E);
            }
            if (G == 256) {
                if (bx >= 128) { if (f < 7) convert_ffn(a, f + 1, lds, (bx - 128) * NWAVES + wave, 128 * NWAVES, wave, lane); if (f < 4) convert_small(a, f, lds, 1023 - ((bx - 128) * NWAVES + wave), 128 * NWAVES, wave, lane); }
            } else {
                if (f < 7) convert_ffn(a, f + 1, lds, bx * NWAVES + wave, G * NWAVES, wave, lane); if (f < 4) convert_small(a, f, lds, bx * NWAVES + wave, G * NWAVES, wave, lane);
            }
            GRID_SYNC();
#ifdef DUP_DOWN
            if (f > 0)             { pg8::EpiResid E{hb, ss + (si + 1) * SSM, nullptr, 0.0f}; GEMM(pg8::EpiResid, ACT, ws + WS_W + (size_t)f * W_FFN_STRIDE + W_FFN_DOWN, D, FF, E); }
#endif
            { pg8::EpiResid E{hb, ss + (si + 1) * SSM, nullptr, 0.5f}; GEMM(pg8::EpiResid, ACT, ws + WS_W + (size_t)f * W_FFN_STRIDE + W_FFN_DOWN, D, FF, E); }
            GRID_SYNC();
        }
    }
    final_phase(a.out, hb, ss + 12 * SSM, a.in[I_FINN], vcu, G, wave, lane);
    asm volatile("s_waitcnt vmcnt(0)" ::: "memory"); __syncthreads(); grid.sync();
}

extern "C" void kernel_launch(void* const* d_in, const int* in_sizes, int n_in, void* d_out, int out_size, void* d_ws, size_t ws_size, hipStream_t stream) {
    static int grid = 0;
    if (grid == 0) {
        if (n_in != 23 || in_sizes[0] != M * D || out_size != M * D || ws_size < WS_END) { fprintf(stderr, "kernel_launch: unexpected shapes (n_in %d, in0 %d, out %d, ws %zu < %zu)\n", n_in, n_in > 0 ? in_sizes[0] : -1, out_size, ws_size, (size_t)WS_END); grid = -1; return; }
        int dev = 0, cus = 0, per_cu = 0;
        if (hipGetDevice(&dev) != hipSuccess || hipDeviceGetAttribute(&cus, hipDeviceAttributeMultiprocessorCount, dev) != hipSuccess) { grid = -1; return; }
        if (hipFuncSetAttribute((const void*)mk_fwd, hipFuncAttributeMaxDynamicSharedMemorySize, LDS_BYTES) != hipSuccess) { fprintf(stderr, "kernel_launch: hipFuncSetAttribute failed\n"); grid = -1; return; }
        if (hipOccupancyMaxActiveBlocksPerMultiprocessor(&per_cu, (const void*)mk_fwd, NTHR, LDS_BYTES) != hipSuccess || per_cu < 1) { fprintf(stderr, "kernel_launch: occupancy query says %d\n", per_cu); per_cu = 1; }
        (void)hipGetLastError();
        grid = cus;
    }
    if (grid < 0) return;
    if (hipMemsetAsync(d_ws, 0, 32768, stream) != hipSuccess) { fprintf(stderr, "kernel_launch: hipMemsetAsync failed\n"); return; }
    Args a{};
    for (int i = 0; i < 23; ++i) a.in[i] = (const float*)d_in[i];
    a.out = (float*)d_out; a.ws = (unsigned char*)d_ws;
    void* args[] = {&a};
    hipError_t e = hipLaunchCooperativeKernel((const void*)mk_fwd, dim3(grid), dim3(NTHR), args, LDS_BYTES, stream);
    if (e != hipSuccess) fprintf(stderr, "cooperative launch failed: %s (grid %d)\n", hipGetErrorString(e), grid);
}
```

```cpp
#include <hip/hip_runtime.h>
#include <hip/hip_cooperative_groups.h>
#include <cstdio>
#include <cstdint>
namespace cg = cooperative_groups;
#ifndef PG8_WGM
#define PG8_WGM 8
#endif
namespace pg8 {
#define PG8_LAS __attribute__((address_space(3)))
typedef unsigned short bf16_t;
typedef short bf16x8 __attribute__((ext_vector_type(8)));
typedef float f32x4 __attribute__((ext_vector_type(4)));
typedef unsigned u32x4 __attribute__((ext_vector_type(4)));
constexpr int BM = 256, BK = 64, HALF = 128, HTB = HALF * BK * 2  , STAGE_BYTES = 8 * HTB, NXCD = 8, WGM = PG8_WGM;

__host__ __device__ __forceinline__ int lds_byte(int r, int c) { const int st = (r >> 4) * 2 + (c >> 5), rr = r & 15, cc = c & 31, ob = rr * 64 + cc * 2; return st * 1024 + (ob ^ (((ob >> 9) & 1) << 5)); }
__host__ __device__ __forceinline__ void stage_rc(int b, int& R, int& C) { const int st = b / 1024, sb = b % 1024, swz = sb ^ (((sb >> 9) & 1) << 5); R = (st >> 1) * 16 + swz / 64; C = (st & 1) * 32 + (swz % 64) / 2; }
__host__ __device__ __forceinline__ int perm32(int rho) { const int n = rho >> 4, i = rho & 15; return 8 * (i >> 2) + 4 * n + (i & 3); }

struct Unit { int pm, pn; };
struct Gemm { const bf16_t* A; const bf16_t* Bt; int M, N, K; };

struct StaticOrder {
    int nM, nN, nwg, G, c;
    __host__ __device__ void init(int M, int N, int G_, int c_) { nM = M / BM; nN = N / BM; nwg = nM * nN; G = G_; c = c_; }
    __host__ __device__ bool next(int i, Unit& u) const {
        const long L = (long)i * G + c; if (L >= nwg) return false;
        int wgid = (int)L; { const int q = nwg / NXCD, r = nwg % NXCD, xcd = wgid % NXCD, off = wgid / NXCD; wgid = (xcd < r ? xcd * (q + 1) : r * (q + 1) + (xcd - r) * q) + off; }
        const int nig = WGM * nN, gid = wgid / nig, fm = gid * WGM, gsz = (nM - fm) < WGM ? (nM - fm) : WGM;
        u.pm = fm + ((wgid % nig) % gsz); u.pn = (wgid % nig) / gsz; return true;
    }
    __device__ __forceinline__ void a_ready(const Unit&) const {}
    __device__ __forceinline__ void done(const Unit&) const {}
};

__device__ __forceinline__ unsigned cvt_pk_bf16(float lo, float hi) { unsigned r; asm volatile("v_cvt_pk_bf16_f32 %0, %1, %2" : "=v"(r) : "v"(lo), "v"(hi)); return r; }
typedef float f32x2 __attribute__((ext_vector_type(2)));

constexpr float RMS_EPS_F = 1e-6f, INV_D = 1.0f / 1024.0f, LOG2E = 1.4426950408889634f;
__device__ __forceinline__ float row_rstd(const float* ss, int row, int fq) { const f32x4 v = *(const f32x4*)(ss + (size_t)row * 16 + 4 * fq); float s = (v[0] + v[1]) + (v[2] + v[3]); s += __shfl_xor(s, 16); s += __shfl_xor(s, 32); return __builtin_amdgcn_rsqf(s * INV_D + RMS_EPS_F); }
__device__ __forceinline__ void row_rstd8(float (&rs)[8], const float* ss, int row0, int fq) {
    f32x4 v[8];
#pragma unroll
    for (int i = 0; i < 8; ++i) v[i] = *(const f32x4*)(ss + (size_t)(row0 + (i >> 2) * HALF + (i & 3) * 16) * 16 + 4 * fq);
#pragma unroll
    for (int i = 0; i < 8; ++i) { float s = (v[i][0] + v[i][1]) + (v[i][2] + v[i][3]); s += __shfl_xor(s, 16); s += __shfl_xor(s, 32); rs[i] = __builtin_amdgcn_rsqf(s * INV_D + RMS_EPS_F); }
}
#ifndef EPI_WT
#define EPI_WT 0
#endif
__device__ __forceinline__ void st16(bf16_t* p, u32x4 w) {
#if EPI_WT
    unsigned long long* q = (unsigned long long*)p;
    __hip_atomic_store(q, (unsigned long long)w.x | ((unsigned long long)w.y << 32), __ATOMIC_RELAXED, __HIP_MEMORY_SCOPE_AGENT);
    __hip_atomic_store(q + 1, (unsigned long long)w.z | ((unsigned long long)w.w << 32), __ATOMIC_RELAXED, __HIP_MEMORY_SCOPE_AGENT);
#else
    *(u32x4*)p = w;
#endif
}
__device__ __forceinline__ float fast_sigmoid(float g) { return __builtin_amdgcn_rcpf(1.0f + __builtin_amdgcn_exp2f(-g * LOG2E)); }

template <int MODE> struct EpiGated {
    static constexpr bool PERM = true, AFTER_DRAIN = false;
    bf16_t* O; int ldc; const float* ss; const float* b0; const float* b1;
    __device__ __forceinline__ void operator()(const f32x4 (&acc)[2][2][4][2], const Unit& u, int wr, int wc, int fr, int fq) const {
#ifdef DUP_GU
        if (ldc < 0) return;
#endif
        const int row0 = u.pm * BM + wr * 64 + fr; const int col0 = u.pn * HALF + wc * 32 + 8 * fq;
        f32x4 bv0[2], bv1[2];
#pragma unroll
        for (int n = 0; n < 2; ++n) { bv0[n] = (MODE == 1) ? *(const f32x4*)(b0 + col0 + 4 * n) : (f32x4){0.f, 0.f, 0.f, 0.f}; bv1[n] = (MODE == 1) ? *(const f32x4*)(b1 + col0 + 4 * n) : (f32x4){0.f, 0.f, 0.f, 0.f}; }
        float rs8[8]; row_rstd8(rs8, ss, row0, fq);
#pragma unroll
        for (int ai = 0; ai < 2; ++ai)
#pragma unroll
            for (int m = 0; m < 4; ++m) { const int row = row0 + ai * HALF + m * 16; const float rstd = rs8[ai * 4 + m];
                u32x4 w; unsigned wv[4];
#pragma unroll
                for (int n = 0; n < 2; ++n) { f32x4 a = acc[ai][0][m][n] * rstd + bv0[n], g = acc[ai][1][m][n] * rstd + bv1[n]; f32x4 o;
#pragma unroll
                    for (int e = 0; e < 4; ++e) { if (MODE == 0) o[e] = a[e] * fast_sigmoid(a[e]) * g[e]; else o[e] = a[e] * fast_sigmoid(g[e]); }
                    wv[2 * n] = cvt_pk_bf16(o[0], o[1]); wv[2 * n + 1] = cvt_pk_bf16(o[2], o[3]); }
                w.x = wv[0]; w.y = wv[1]; w.z = wv[2]; w.w = wv[3];
                st16(O + (size_t)row * ldc + col0, w); }
    }
};
struct EpiScaleBf16 {
    static constexpr bool PERM = true, AFTER_DRAIN = false;
    bf16_t* O; int ldc; const float* ss; int split_cols; size_t split_stride; float sc;
    __device__ __forceinline__ void operator()(const f32x4 (&acc)[2][2][4][2], const Unit& u, int wr, int wc, int fr, int fq) const {
        const int row0 = u.pm * BM + wr * 64 + fr; int colt = u.pn * BM; bf16_t* base = O;
        if (split_cols) { const int t = colt / split_cols; base += (size_t)t * split_stride; colt -= t * split_cols; }
        const int col0 = colt + wc * 32 + 8 * fq;
        float rs8[8]; row_rstd8(rs8, ss, row0, fq);
#pragma unroll
        for (int ai = 0; ai < 2; ++ai)
#pragma unroll
            for (int m = 0; m < 4; ++m) { const int row = row0 + ai * HALF + m * 16; const float rs = rs8[ai * 4 + m] * sc;
                bf16_t* rowp = base + (size_t)row * ldc + col0;
#pragma unroll
                for (int bj = 0; bj < 2; ++bj) { const f32x4 v0 = acc[ai][bj][m][0] * rs, v1 = acc[ai][bj][m][1] * rs;
                    u32x4 w; w.x = cvt_pk_bf16(v0[0], v0[1]); w.y = cvt_pk_bf16(v0[2], v0[3]); w.z = cvt_pk_bf16(v1[0], v1[1]); w.w = cvt_pk_bf16(v1[2], v1[3]);
                    st16(rowp + bj * HALF, w); } }
    }
};
__device__ __forceinline__ float bf_lo(unsigned w) { return __uint_as_float(w << 16); }
__device__ __forceinline__ float bf_hi(unsigned w) { return __uint_as_float(w & 0xffff0000u); }
struct EpiResid {
    static constexpr bool PERM = true, AFTER_DRAIN = false;
    bf16_t* hb; float* ssn; const float* bias; float alpha;
    __device__ __forceinline__ void operator()(const f32x4 (&acc)[2][2][4][2], const Unit& u, int wr, int wc, int fr, int fq) const {
#ifdef DUP_DOWN
        if (alpha == 0.0f) return;
#endif
        const int row0 = u.pm * BM + wr * 64 + fr; const int col0 = u.pn * BM + wc * 32 + 8 * fq;
        f32x4 bv[2][2];
#pragma unroll
        for (int bj = 0; bj < 2; ++bj)
#pragma unroll
            for (int n = 0; n < 2; ++n) bv[bj][n] = bias ? *(const f32x4*)(bias + col0 + bj * HALF + 4 * n) : (f32x4){0.f, 0.f, 0.f, 0.f};
        u32x4 pre[3][2];
#define RES_LOAD(it_) do { const size_t off_ = (size_t)(row0 + ((it_) >> 2) * HALF + ((it_) & 3) * 16) * 1024 + col0; \
            _Pragma("unroll") for (int bj = 0; bj < 2; ++bj) pre[(it_) % 3][bj] = *(const u32x4*)(hb + off_ + bj * HALF); } while (0)
        RES_LOAD(0); RES_LOAD(1); RES_LOAD(2);
#pragma unroll
        for (int it = 0; it < 8; ++it) { const int ai = it >> 2, m = it & 3; const int row = row0 + ai * HALF + m * 16; const size_t off = (size_t)row * 1024 + col0; float s = 0.f;
            u32x4 w[2];
#pragma unroll
            for (int bj = 0; bj < 2; ++bj) { const u32x4 hw = pre[it % 3][bj];
                const f32x4 h0 = (f32x4){bf_lo(hw.x), bf_hi(hw.x), bf_lo(hw.y), bf_hi(hw.y)}, h1 = (f32x4){bf_lo(hw.z), bf_hi(hw.z), bf_lo(hw.w), bf_hi(hw.w)};
                const f32x4 o0 = h0 + (acc[ai][bj][m][0] + bv[bj][0]) * alpha, o1 = h1 + (acc[ai][bj][m][1] + bv[bj][1]) * alpha;
                w[bj].x = cvt_pk_bf16(o0[0], o0[1]); w[bj].y = cvt_pk_bf16(o0[2], o0[3]); w[bj].z = cvt_pk_bf16(o1[0], o1[1]); w[bj].w = cvt_pk_bf16(o1[2], o1[3]);
                s += ((o0[0] * o0[0] + o0[1] * o0[1]) + (o0[2] * o0[2] + o0[3] * o0[3])) + ((o1[0] * o1[0] + o1[1] * o1[1]) + (o1[2] * o1[2] + o1[3] * o1[3])); }
            if (it + 3 < 8) RES_LOAD(it + 3);
#pragma unroll
            for (int bj = 0; bj < 2; ++bj) st16(hb + off + bj * HALF, w[bj]);
            s += __shfl_xor(s, 16); s += __shfl_xor(s, 32);
            if (fq == 0) ssn[(size_t)row * 16 + u.pn * 4 + wc] = s; }
#undef RES_LOAD
    }
};
#ifndef PG8_AUXA
#define PG8_AUXA 0
#endif
#ifndef PG8_AUXB
#define PG8_AUXB 0
#endif
template <class Epi, class Sched, bool ALIGN_EPI = false, bool SP2 = false>
__device__ __forceinline__ void gemm_phase(PG8_LAS unsigned char* lds, const Gemm g, const Sched& S, const Epi& E) {
    int tid_ = threadIdx.x; asm volatile("" : "+v"(tid_)); const int tid = tid_, wid = __builtin_amdgcn_readfirstlane(tid >> 6), lane = tid & 63, wr = wid >> 2, wc = wid & 3, fr = lane & 15, fq = lane >> 4;
    const int K = g.K, nt = K / BK;
    unsigned voffA[2], voffB[2];
#pragma unroll
    for (int i = 0; i < 2; ++i) { int R, C; stage_rc(tid * 16 + i * 8192, R, C); const int Rb = Epi::PERM ? ((R & ~31) + perm32(R & 31)) : R;
        voffA[i] = (unsigned)(R * K + C) * 2u; voffB[i] = (unsigned)(Rb * K + C) * 2u; }
    const size_t kstep = (size_t)(BK * 2);
    const size_t hstep = (size_t)HALF * K * 2;
    const size_t tstep = 2 * hstep;
    const unsigned ldsw = (unsigned)wid * 1024u;
    const int aoff = lds_byte(wr * 64 + fr, fq * 8), boff = lds_byte(wc * 32 + fr, fq * 8);
#define PG8_SA(b, h) (((b) * 2 + (h)) * HTB)
#define PG8_SB(b, h) ((4 + (b) * 2 + (h)) * HTB)
#define PG8_STAGE(bufoff, gbase, voff) do { _Pragma("unroll") for (int _i = 0; _i < 2; ++_i) \
        __builtin_amdgcn_global_load_lds((const unsigned*)((const char*)(gbase) + (voff)[_i]), (PG8_LAS unsigned*)(lds + (bufoff) + ldsw + _i * 8192), 16, 0, ((bufoff) >= 4 * HTB) ? PG8_AUXB : PG8_AUXA); } while (0)
#define PG8_LDA(dst, b, h) do { _Pragma("unroll") for (int m = 0; m < 4; ++m) _Pragma("unroll") for (int k = 0; k < 2; ++k) dst[m][k] = *(const PG8_LAS bf16x8*)(lds + PG8_SA(b, h) + aoff + m * 2048 + k * 1024); } while (0)
#define PG8_LDB(dst, b, h) do { _Pragma("unroll") for (int n = 0; n < 2; ++n) _Pragma("unroll") for (int k = 0; k < 2; ++k) dst[n][k] = *(const PG8_LAS bf16x8*)(lds + PG8_SB(b, h) + boff + n * 2048 + k * 1024); } while (0)
#define PG8_MMA(ai, bj, At, Bt) do { __builtin_amdgcn_s_setprio(1); _Pragma("unroll") for (int m = 0; m < 4; ++m) _Pragma("unroll") for (int n = 0; n < 2; ++n) _Pragma("unroll") for (int k = 0; k < 2; ++k) \
        acc[ai][bj][m][n] = __builtin_amdgcn_mfma_f32_16x16x32_bf16(Bt[n][k], At[m][k], acc[ai][bj][m][n], 0, 0, 0); __builtin_amdgcn_s_setprio(0); } while (0)
#define PG8_WAIT_V(n) asm volatile("s_waitcnt vmcnt(" #n ")" ::: "memory")
#define PG8_WAIT_L(n) asm volatile("s_waitcnt lgkmcnt(" #n ")" ::: "memory")
#define PG8_BAR __builtin_amdgcn_s_barrier()
#define PG8_SCHED __builtin_amdgcn_sched_barrier(0)
    Unit cur, nxt; int ui = 0;
    if (!S.next(0, cur)) return;
    f32x4 acc[2][2][4][2];
#pragma unroll
    for (int a = 0; a < 2; ++a)
#pragma unroll
        for (int b = 0; b < 2; ++b)
#pragma unroll
            for (int m = 0; m < 4; ++m)
#pragma unroll
                for (int n = 0; n < 2; ++n) acc[a][b][m][n] = (f32x4){0.f, 0.f, 0.f, 0.f};
    bf16x8 At[4][2], B0[2][2], B1[2][2];
    const char* cA = (const char*)g.A + (size_t)cur.pm * tstep; const char* cB = (const char*)g.Bt + (size_t)cur.pn * tstep;
    S.a_ready(cur);
    if constexpr (SP2) {
        PG8_STAGE(PG8_SB(0, 0), cB, voffB); PG8_STAGE(PG8_SB(0, 1), cB + hstep, voffB); PG8_STAGE(PG8_SA(0, 0), cA, voffA); PG8_STAGE(PG8_SA(0, 1), cA + hstep, voffA);
        if (wr == 1) PG8_BAR;
        PG8_WAIT_V(2); PG8_BAR;
        PG8_STAGE(PG8_SB(1, 0), cB + kstep, voffB); PG8_STAGE(PG8_SA(1, 0), cA + kstep, voffA); PG8_STAGE(PG8_SB(1, 1), cB + hstep + kstep, voffB);
        PG8_WAIT_V(6); PG8_BAR;
    } else {
        PG8_STAGE(PG8_SB(0, 0), cB, voffB); PG8_STAGE(PG8_SA(0, 0), cA, voffA); PG8_STAGE(PG8_SB(0, 1), cB + hstep, voffB); PG8_STAGE(PG8_SA(0, 1), cA + hstep, voffA);
        if (wr == 1) PG8_BAR;
        PG8_WAIT_V(4); PG8_BAR;
        PG8_STAGE(PG8_SB(1, 0), cB + kstep, voffB); PG8_STAGE(PG8_SA(1, 0), cA + kstep, voffA); PG8_STAGE(PG8_SB(1, 1), cB + hstep + kstep, voffB);
        PG8_WAIT_V(6); PG8_BAR;
    }
    for (;;) {
        const bool has_next = S.next(ui + 1, nxt);
        const char* nA = has_next ? (const char*)g.A + (size_t)nxt.pm * tstep : cA; const char* nB = has_next ? (const char*)g.Bt + (size_t)nxt.pn * tstep : cB;
        for (int t = 0; t < nt; t += 2) {
            const bool last = (t == nt - 2);
            const char* a1 = cA + (size_t)(t + 1) * kstep;
            const char* a2 = last ? nA : cA + (size_t)(t + 2) * kstep; const char* b2 = last ? nB : cB + (size_t)(t + 2) * kstep;
            const char* a3 = a2 + kstep; const char* b3 = b2 + kstep;
            if (last && has_next) S.a_ready(nxt);
            if constexpr (SP2) {
            PG8_LDB(B0, 0, 0); PG8_LDB(B1, 0, 1); PG8_SCHED; PG8_LDA(At, 0, 0); PG8_STAGE(PG8_SA(1, 1), a1 + hstep, voffA);
            PG8_WAIT_V(8); PG8_WAIT_L(0); PG8_BAR; PG8_MMA(0, 0, At, B0); PG8_MMA(0, 1, At, B1); PG8_BAR; PG8_SCHED;
            PG8_LDA(At, 0, 1); PG8_STAGE(PG8_SB(0, 0), b2, voffB); PG8_STAGE(PG8_SB(0, 1), b2 + hstep, voffB); PG8_STAGE(PG8_SA(0, 0), a2, voffA);
            PG8_WAIT_V(8); PG8_WAIT_L(0); PG8_BAR; PG8_MMA(1, 0, At, B0); PG8_MMA(1, 1, At, B1); PG8_BAR; PG8_SCHED;
            PG8_LDB(B0, 1, 0); PG8_LDB(B1, 1, 1); PG8_SCHED; PG8_LDA(At, 1, 0); PG8_STAGE(PG8_SA(0, 1), a2 + hstep, voffA);
            PG8_WAIT_V(8); PG8_WAIT_L(0); PG8_BAR; PG8_MMA(0, 0, At, B0); PG8_MMA(0, 1, At, B1); PG8_BAR; PG8_SCHED;
            PG8_LDA(At, 1, 1); PG8_STAGE(PG8_SB(1, 0), b3, voffB); PG8_STAGE(PG8_SB(1, 1), b3 + hstep, voffB); PG8_STAGE(PG8_SA(1, 0), a3, voffA);
            PG8_WAIT_V(8); PG8_WAIT_L(0); PG8_BAR; PG8_MMA(1, 0, At, B0); PG8_MMA(1, 1, At, B1); PG8_BAR; PG8_SCHED;
            } else {
            PG8_LDB(B0, 0, 0); PG8_SCHED; PG8_LDA(At, 0, 0); PG8_STAGE(PG8_SA(1, 1), a1 + hstep, voffA);
            PG8_WAIT_L(8); PG8_BAR; PG8_WAIT_L(0); PG8_MMA(0, 0, At, B0); PG8_BAR; PG8_SCHED;
            PG8_LDB(B1, 0, 1); PG8_STAGE(PG8_SB(0, 0), b2, voffB);
            PG8_BAR; PG8_WAIT_L(0); PG8_MMA(0, 1, At, B1); PG8_BAR;
            PG8_LDA(At, 0, 1); PG8_STAGE(PG8_SA(0, 0), a2, voffA);
            PG8_BAR; PG8_WAIT_L(0); PG8_MMA(1, 0, At, B0); PG8_BAR; PG8_SCHED;
            PG8_STAGE(PG8_SB(0, 1), b2 + hstep, voffB);
            PG8_WAIT_V(6); PG8_BAR; PG8_MMA(1, 1, At, B1); PG8_BAR;
            PG8_LDB(B0, 1, 0); PG8_SCHED; PG8_LDA(At, 1, 0); PG8_STAGE(PG8_SA(0, 1), a2 + hstep, voffA);
            PG8_WAIT_L(8); PG8_BAR; PG8_WAIT_L(0); PG8_MMA(0, 0, At, B0); PG8_BAR; PG8_SCHED;
            PG8_LDB(B1, 1, 1); PG8_STAGE(PG8_SB(1, 0), b3, voffB);
            PG8_BAR; PG8_WAIT_L(0); PG8_MMA(0, 1, At, B1); PG8_BAR;
            PG8_LDA(At, 1, 1); PG8_STAGE(PG8_SA(1, 0), a3, voffA);
            PG8_BAR; PG8_WAIT_L(0); PG8_MMA(1, 0, At, B0); PG8_BAR; PG8_SCHED;
            PG8_STAGE(PG8_SB(1, 1), b3 + hstep, voffB);
            PG8_WAIT_V(6); PG8_BAR; PG8_MMA(1, 1, At, B1); PG8_BAR;
            }
        }
        if constexpr (ALIGN_EPI) { if (wr == 0) PG8_BAR; }
        if constexpr (!Epi::AFTER_DRAIN) { E(acc, cur, wr, wc, fr, fq); S.done(cur); }
        if (!has_next) break;
#pragma unroll
        for (int a = 0; a < 2; ++a)
#pragma unroll
            for (int b = 0; b < 2; ++b)
#pragma unroll
                for (int m = 0; m < 4; ++m)
#pragma unroll
                    for (int n = 0; n < 2; ++n) acc[a][b][m][n] = (f32x4){0.f, 0.f, 0.f, 0.f};
        cur = nxt; cA = nA; cB = nB; ++ui;
        if constexpr (ALIGN_EPI) { if (wr == 1) PG8_BAR; }
    }
    PG8_WAIT_V(0);
    if constexpr (!ALIGN_EPI) { if (wr == 0) PG8_BAR; }
    PG8_BAR;
    if constexpr (Epi::AFTER_DRAIN) { E.fused(acc, cur, wr, wc, fr, fq, lds, wid, lane); S.done(cur); }
#undef PG8_SA
#undef PG8_SB
#undef PG8_STAGE
#undef PG8_LDA
#undef PG8_LDB
#undef PG8_MMA
#undef PG8_WAIT_V
#undef PG8_WAIT_L
#undef PG8_BAR
#undef PG8_SCHED
}
}

constexpr int NWAVES = 8, NTHR = 512;
constexpr int BATCH = 8, SEQ = 2048, D = 1024, FF = 2816, NH = 16, HD = 64, CW = 31;
constexpr int M = BATCH * SEQ;
constexpr size_t MiB = 1u << 20;
constexpr size_t WS_SS = 344 * MiB;
constexpr size_t WS_HB = 2 * MiB;
constexpr size_t WS_K = 34 * MiB, WS_V = 66 * MiB;
constexpr size_t WS_ACT = 98 * MiB;
constexpr size_t WS_W = 186 * MiB;
constexpr size_t W_FFN_STRIDE = 16 * MiB + MiB / 2, W_FFN_DOWN = 11 * MiB;
constexpr size_t WS_WX = WS_W + 8 * W_FFN_STRIDE;
constexpr size_t WS_END = WS_SS + 13 * MiB;
constexpr int SSM = M * 16;
constexpr int NSS = 13;
constexpr int LDS_BYTES = 147456;

#define GAS __attribute__((address_space(1)))
#define LAS __attribute__((address_space(3)))
typedef unsigned short bf16;
typedef unsigned v4u __attribute__((ext_vector_type(4)));
typedef float f32x4 __attribute__((ext_vector_type(4)));
typedef float f32x2 __attribute__((ext_vector_type(2)));
typedef short bf16x8 __attribute__((ext_vector_type(8)));
#define LDS_WAIT() asm volatile("s_waitcnt lgkmcnt(0)" ::: "memory")
#define VM_WAIT() asm volatile("s_waitcnt vmcnt(0)" ::: "memory")
typedef __bf16 bf16x2_t __attribute__((ext_vector_type(2)));
__device__ __forceinline__ unsigned pk2(float lo, float hi) { f32x2 v = {lo, hi}; bf16x2_t b = __builtin_convertvector(v, bf16x2_t); return __builtin_bit_cast(unsigned, b); }
__device__ __forceinline__ float wave_sum(float v) {
#pragma unroll
    for (int o = 1; o < 64; o <<= 1) v += __shfl_xor(v, o);
    return v;
}

struct Args { const float* in[23]; float* out; unsigned char* ws; };
enum { I_X = 0, I_F1N, I_F1G, I_F1U, I_F1D, I_MIXN, I_F2N, I_F2G, I_F2U, I_F2D, I_PW1, I_BPW1, I_WDW, I_BDW, I_LNG, I_LNB, I_PW2, I_BPW2, I_KVN, I_WKV, I_WQ, I_WO, I_FINN };

__device__ __forceinline__ void xpose_item(const float* W, int K, int N, const float* gain, bf16* WT, int mode, LAS float* scr, int item, int lane) {
    const int nblk = N / 64, kb = item / nblk, nb = item % nblk, k0 = 64 * kb, n0 = 64 * nb;
    int d0 = n0;
    if (mode == 1) d0 = 256 * (n0 >> 7) + (n0 & 127);
    else if (mode == 2) d0 = 256 * (n0 >> 7) + 128 + (n0 & 127);
    else if (mode == 3) { const int nn = n0 & 1023; d0 = 256 * (nn >> 7) + 128 * (n0 >> 10) + (nn & 127); }
    const float* src = W + (size_t)k0 * N + n0 + lane;
    float v[64];
#pragma unroll
    for (int i = 0; i < 64; ++i) v[i] = src[(size_t)i * N];
    if (gain) {
#pragma unroll
        for (int i = 0; i < 64; ++i) v[i] *= gain[k0 + i];
    }
#pragma unroll
    for (int i = 0; i < 64; ++i) scr[i * 65 + lane] = v[i];
    LDS_WAIT(); asm volatile("" ::: "memory");
    const int c = lane & 7;
#pragma unroll
    for (int j = 0; j < 8; ++j) { const int n = (lane >> 3) + 8 * j; const LAS float* s = scr + (8 * c) * 65 + n;
        v4u o; o.x = pk2(s[0 * 65], s[1 * 65]); o.y = pk2(s[2 * 65], s[3 * 65]); o.z = pk2(s[4 * 65], s[5 * 65]); o.w = pk2(s[6 * 65], s[7 * 65]);
        *(GAS v4u*)(WT + (size_t)(d0 + n) * K + k0 + 8 * c) = o; }
    LDS_WAIT(); asm volatile("" ::: "memory");
}

__device__ __forceinline__ void convert_ffn(const Args& a, int f, LAS unsigned char* lds, int iw, int nw, int wave, int lane_) {
    int lane = lane_; asm volatile("" : "+v"(lane));
    LAS float* scr = (LAS float*)(lds + wave * 16640);
    const int l = f >> 1, which = f & 1; unsigned char* ws = a.ws;
    bf16* wb = (bf16*)(ws + WS_W + (size_t)f * W_FFN_STRIDE);
    const float* gain = a.in[which ? I_F2N : I_F1N] + l * D;
    for (int it = iw; it < 3 * 704; it += nw) {
        const int kind = it / 704, r = it - kind * 704;
        if (kind == 0) xpose_item(a.in[which ? I_F2G : I_F1G] + (size_t)l * D * FF, D, FF, gain, wb, 1, scr, r, lane);
        else if (kind == 1) xpose_item(a.in[which ? I_F2U : I_F1U] + (size_t)l * D * FF, D, FF, gain, wb, 2, scr, r, lane);
        else xpose_item(a.in[which ? I_F2D : I_F1D] + (size_t)l * D * FF, FF, D, nullptr, (bf16*)(ws + WS_W + (size_t)f * W_FFN_STRIDE + W_FFN_DOWN), 0, scr, r, lane);
    }
}
__device__ __forceinline__ void convert_small(const Args& a, int grp, LAS unsigned char* lds, int iw, int nw, int wave, int lane_) {
    int lane = lane_; asm volatile("" : "+v"(lane));
    LAS float* scr = (LAS float*)(lds + wave * 16640); unsigned char* ws = a.ws;
    for (int it = iw; it < 768; it += nw) {
        if (grp < 2) {
            if (it < 512) xpose_item(a.in[I_PW1] + (size_t)grp * D * 2 * D, D, 2 * D, a.in[I_MIXN] + grp * D, (bf16*)(ws + WS_WX + (size_t)grp * 4 * MiB), 3, scr, it, lane);
            else xpose_item(a.in[I_PW2] + (size_t)grp * D * D, D, D, nullptr, (bf16*)(ws + WS_WX + (12 + 2 * grp) * MiB), 0, scr, it - 512, lane);
        } else if (grp == 2) {
            if (it < 512) xpose_item(a.in[I_WKV], D, 2 * D, a.in[I_KVN], (bf16*)(ws + WS_WX + 8 * MiB), 0, scr, it, lane);
            else xpose_item(a.in[I_WQ], D, D, a.in[I_MIXN] + 2 * D, (bf16*)(ws + WS_WX + 16 * MiB), 0, scr, it - 512, lane);
        } else {
            if (it < 256) xpose_item(a.in[I_WO], D, D, nullptr, (bf16*)(ws + WS_WX + 20 * MiB), 0, scr, it, lane);
            else if (it < 512) xpose_item(a.in[I_WQ] + (size_t)D * D, D, D, a.in[I_MIXN] + 3 * D, (bf16*)(ws + WS_WX + 18 * MiB), 0, scr, it - 256, lane);
            else xpose_item(a.in[I_WO] + (size_t)D * D, D, D, nullptr, (bf16*)(ws + WS_WX + 22 * MiB), 0, scr, it - 512, lane);
        }
    }
}
__device__ __forceinline__ void prologue_phase(const Args& a, LAS unsigned char* lds, int vcu, int G, int wave, int lane) {
    LAS float* scr = (LAS float*)(lds + wave * 16640);
    const int gw = vcu * NWAVES + wave, NGW = G * NWAVES;
    unsigned char* ws = a.ws;
    convert_ffn(a, 0, lds, gw, NGW, wave, lane);
    float* ss = (float*)(ws + WS_SS); bf16* hb = (bf16*)(ws + WS_HB);
    const int rstart = (G == 256) ? (vcu >> 5) * (M / 8) + (vcu & 31) * NWAVES + wave : gw, rstep = (G == 256) ? 256 : NGW, rend = (G == 256) ? ((vcu >> 5) + 1) * (M / 8) : M;
    for (int m0 = rstart; m0 < rend; m0 += 4 * rstep) {
        f32x4 v[4][4];
#pragma unroll
        for (int q = 0; q < 4; ++q) { const int m = m0 + q * rstep; if (m < rend) { const GAS f32x4* xr = (const GAS f32x4*)(a.in[I_X] + (size_t)m * D) + lane;
#pragma unroll
            for (int j = 0; j < 4; ++j) v[q][j] = xr[64 * j]; } }
#pragma unroll
        for (int q = 0; q < 4; ++q) { const int m = m0 + q * rstep; if (m < rend) { float s = 0.f;
#pragma unroll
            for (int j = 0; j < 4; ++j) s += (v[q][j].x * v[q][j].x + v[q][j].y * v[q][j].y) + (v[q][j].z * v[q][j].z + v[q][j].w * v[q][j].w);
            s = wave_sum(s); if (lane < 16) ss[(size_t)m * 16 + lane] = (lane == 0) ? s : 0.f;
            GAS unsigned long long* o8 = (GAS unsigned long long*)(hb + (size_t)m * D) + lane;
#pragma unroll
            for (int j = 0; j < 4; ++j) o8[64 * j] = (unsigned long long)pk2(v[q][j].x, v[q][j].y) | ((unsigned long long)pk2(v[q][j].z, v[q][j].w) << 32); } }
    }
}

__device__ __forceinline__ void final_phase(float* out, const bf16* hb, const float* ss, const float* g, int vcu, int G, int wave, int lane) {
    const int gw = vcu * NWAVES + wave, NGW = G * NWAVES;
    f32x4 gv[2][2];
#pragma unroll
    for (int j = 0; j < 2; ++j) { gv[j][0] = *(const f32x4*)(g + 512 * j + 8 * lane); gv[j][1] = *(const f32x4*)(g + 512 * j + 8 * lane + 4); }
    const int rstart = (G == 256) ? (vcu >> 5) * (M / 8) + (vcu & 31) * NWAVES + wave : gw, rstep = (G == 256) ? 256 : NGW, rend = (G == 256) ? ((vcu >> 5) + 1) * (M / 8) : M;
    for (int m0 = rstart; m0 < rend; m0 += 4 * rstep) {
        float sq[4]; v4u hw[4][2];
#pragma unroll
        for (int q = 0; q < 4; ++q) { const int m = m0 + q * rstep; if (m < rend) { sq[q] = ss[(size_t)m * 16 + (lane & 15)];
#pragma unroll
            for (int j = 0; j < 2; ++j) hw[q][j] = *(const GAS v4u*)(hb + (size_t)m * D + 512 * j + 8 * lane); } }
#pragma unroll
        for (int q = 0; q < 4; ++q) { const int m = m0 + q * rstep; if (m < rend) { float t = sq[q]; t += __shfl_xor(t, 1); t += __shfl_xor(t, 2); t += __shfl_xor(t, 4); t += __shfl_xor(t, 8); const float rstd = __builtin_amdgcn_rsqf(t * (1.0f / D) + 1e-6f);
#pragma unroll
            for (int j = 0; j < 2; ++j) { const v4u w = hw[q][j];
                const f32x4 h0 = (f32x4){pg8::bf_lo(w.x), pg8::bf_hi(w.x), pg8::bf_lo(w.y), pg8::bf_hi(w.y)}, h1 = (f32x4){pg8::bf_lo(w.z), pg8::bf_hi(w.z), pg8::bf_lo(w.w), pg8::bf_hi(w.w)};
                GAS f32x4* o = (GAS f32x4*)(out + (size_t)m * D + 512 * j + 8 * lane); o[0] = h0 * rstd * gv[j][0]; o[1] = h1 * rstd * gv[j][1]; } } }
    }
}

__device__ __forceinline__ void dwconv_phase(const bf16* glu, bf16* cv, const float* wdw, const float* bdw, const float* lng, const float* lnb, LAS unsigned char* lds, int vcu, int G) {
    constexpr int TT = 16, NIN = TT + CW - 1, RS = 520;
    int tid_ = threadIdx.x; asm volatile("" : "+v"(tid_)); const int tid = tid_, c = 2 * tid;
    f32x2 w[CW];
#pragma unroll
    for (int j = 0; j < CW; ++j) w[j] = *(const f32x2*)(wdw + j * D + c);
    const f32x2 bd = *(const f32x2*)(bdw + c), gg = *(const f32x2*)(lng + c), bb = *(const f32x2*)(lnb + c);
    LAS float* red = (LAS float*)lds; LAS float* fin = (LAS float*)(lds + 2 * TT * RS * 4);
    const int ntile = M / TT, tstart = (G == 256) ? (vcu >> 5) * (ntile / 8) + (vcu & 31) : vcu, tstep = (G == 256) ? 32 : G, tend = (G == 256) ? ((vcu >> 5) + 1) * (ntile / 8) : ntile;
    for (int tile = tstart; tile < tend; tile += tstep) {
        const int m0 = tile * TT, t0 = m0 & (SEQ - 1);
        unsigned in[NIN];
#pragma unroll
        for (int i = 0; i < NIN; ++i) { in[i] = 0u; if (t0 - (CW - 1) + i >= 0) in[i] = *(const unsigned*)(glu + (size_t)(m0 - (CW - 1) + i) * D + c); }
        f32x2 o[TT];
#pragma unroll
        for (int t = 0; t < TT; ++t) o[t] = bd;
#pragma unroll
        for (int i = 0; i < NIN; ++i) { f32x2 x; x.x = __uint_as_float(in[i] << 16); x.y = __uint_as_float(in[i] & 0xffff0000u);
#pragma unroll
            for (int t = 0; t < TT; ++t) { const int j = i - t; if (j >= 0 && j < CW) o[t] += w[j] * x; } }
#pragma unroll
        for (int t = 0; t < TT; ++t) { red[(2 * t) * RS + tid] = o[t].x + o[t].y; red[(2 * t + 1) * RS + tid] = o[t].x * o[t].x + o[t].y * o[t].y; }
        __syncthreads();
        { const int v = tid >> 4, j = tid & 15; float s = 0.f;
#pragma unroll
          for (int i = 0; i < 32; ++i) s += red[v * RS + j + 16 * i];
          s += __shfl_xor(s, 8); s += __shfl_xor(s, 4); s += __shfl_xor(s, 2); s += __shfl_xor(s, 1);
          if (j == 0) fin[v] = s; }
        __syncthreads();
#pragma unroll
        for (int t = 0; t < TT; ++t) { const float mean = fin[2 * t] * (1.0f / D), var = fin[2 * t + 1] * (1.0f / D) - mean * mean, rstd = __builtin_amdgcn_rsqf(var + 1e-5f);
            f32x2 y = (o[t] - mean) * rstd * gg + bb; y.x = y.x * pg8::fast_sigmoid(y.x); y.y = y.y * pg8::fast_sigmoid(y.y);
            *(unsigned*)(cv + (size_t)(m0 + t) * D + c) = pk2(y.x, y.y); }
    }
    __syncthreads();
}

namespace sba {
typedef short s16x4 __attribute__((ext_vector_type(4)));
typedef float f32x16 __attribute__((ext_vector_type(16)));
typedef short v4i16_t __attribute__((ext_vector_type(4)));
typedef LAS const char* lds_cptr;
__device__ __forceinline__ int crow(int r, int hi) { return (r & 3) + 8 * (r >> 2) + 4 * hi; }
__device__ __forceinline__ s16x4 vtr(lds_cptr p) { return __builtin_bit_cast(s16x4, __builtin_amdgcn_ds_read_tr16_b64_v4i16((LAS v4i16_t*)p)); }

constexpr float FSTOP = 5.9604644775e-08f;
__device__ __forceinline__ void attn_item4(int b, int h, int qblk, const bf16* Q, const bf16* __restrict__ K, const bf16* __restrict__ V, bf16* O, LAS unsigned char* wl  , int lane) {
    const int r32 = lane & 31, hi = lane >> 5;
    const long rowbase = (long)b * SEQ; const int t0 = qblk * 32;
    const bf16* Qw = Q + (rowbase + t0) * D + h * HD;
    const bf16* kg = K + rowbase * D + h * HD + (long)r32 * D + hi * 8;
    const bf16* vsrc = V + rowbase * D + h * HD + (long)(lane >> 2) * D + (lane & 3) * 8;
#define SB_KLD(dst_, j_) do { _Pragma("unroll") for (int d0_ = 0; d0_ < 4; ++d0_) dst_[d0_] = *(const bf16x8*)(kg + (long)(j_) * 32 * D + d0_ * 16); } while (0)
#define SB_VDMA(j_, slot_) do { _Pragma("unroll") for (int c_ = 0; c_ < 4; ++c_) \
        __builtin_amdgcn_global_load_lds((const unsigned*)(vsrc + (long)((j_) * 32 + 16 * (c_ & 1)) * D + (c_ >> 1) * 32), (LAS unsigned*)(wl + (slot_) * 4096 + c_ * 1024), 16, 0, 0); } while (0)
    const lds_cptr vp0 = (lds_cptr)wl + ((lane >> 4) & 1) * 32 + (lane & 3) * 8 + (4 * hi + ((lane & 15) >> 2)) * 64;
    const int j0 = qblk;
    bf16x8 k0[4], k1[4], k2[4], qr[4];
#pragma unroll
    for (int d0 = 0; d0 < 4; ++d0) { k1[d0] = bf16x8{}; k2[d0] = bf16x8{}; }
    SB_KLD(k0, j0); SB_VDMA(j0, 0);
#pragma unroll
    for (int d0 = 0; d0 < 4; ++d0) qr[d0] = *(const bf16x8*)(Qw + (long)r32 * D + d0 * 16 + hi * 8);
    if (j0 >= 1) { SB_KLD(k1, j0 - 1); SB_VDMA(j0 - 1, 1); }
    if (j0 >= 2) { SB_KLD(k2, j0 - 2); SB_VDMA(j0 - 2, 2); }
    f32x16 o[2]; o[0] = f32x16{}; o[1] = f32x16{};
    float F = 1.0f;
    const int qpos = t0 + r32;
    for (int j = j0; j >= 0; --j) {
        const int slot = (j0 - j) & 3;
        if (j >= 2) asm volatile("s_waitcnt vmcnt(16)" ::: "memory"); else if (j == 1) asm volatile("s_waitcnt vmcnt(8)" ::: "memory"); else asm volatile("s_waitcnt vmcnt(0)" ::: "memory");
        f32x16 p = __builtin_amdgcn_mfma_f32_32x32x16_bf16(k0[0], qr[0], f32x16{}, 0, 0, 0);
#pragma unroll
        for (int d0 = 1; d0 < 4; ++d0) p = __builtin_amdgcn_mfma_f32_32x32x16_bf16(k0[d0], qr[d0], p, 0, 0, 0);
        const bool diag = (j == j0);
        float beta[16], om[16];
#pragma unroll
        for (int r = 0; r < 16; ++r) { const float e = __builtin_amdgcn_exp2f(-p[r]); float bt = __builtin_amdgcn_rcpf(1.0f + e); float m1 = 1.0f - bt;
            if (diag) { const int kv = 32 * j + crow(r, hi); if (kv >= qpos) { bt = 0.f; m1 = 1.f; } }
            beta[r] = bt; om[r] = m1; }
        float A1[4], A0[4], T[4], PT[4];
#pragma unroll
        for (int g = 0; g < 4; ++g) { A1[g] = om[4 * g + 3] * om[4 * g + 2]; A0[g] = A1[g] * om[4 * g + 1]; T[g] = A0[g] * om[4 * g]; }
#pragma unroll
        for (int g = 0; g < 4; ++g) PT[g] = __shfl_xor(T[g], 32);
        float X = 1.f, carry[4];
#pragma unroll
        for (int g = 3; g >= 0; --g) { carry[g] = F * X * (hi == 0 ? PT[g] : 1.f); X *= T[g] * PT[g]; }
        F *= X;
        unsigned pw[2][4];
#pragma unroll
        for (int g = 0; g < 4; ++g) { const float w3 = beta[4 * g + 3] * carry[g], w2 = beta[4 * g + 2] * (carry[g] * om[4 * g + 3]), w1 = beta[4 * g + 1] * (carry[g] * A1[g]), w0 = beta[4 * g] * (carry[g] * A0[g]);
            pw[g >> 1][(g & 1) * 2] = pk2(w0, w1); pw[g >> 1][(g & 1) * 2 + 1] = pk2(w2, w3); }
        const lds_cptr vp = vp0 + slot * 4096;
#pragma unroll
        for (int d0 = 0; d0 < 2; ++d0)
#pragma unroll
            for (int ks = 0; ks < 2; ++ks) { const s16x4 lo = vtr(vp + d0 * 2048 + ks * 1024), hh = vtr(vp + d0 * 2048 + ks * 1024 + 512);
                const bf16x8 vf = (bf16x8){lo[0], lo[1], lo[2], lo[3], hh[0], hh[1], hh[2], hh[3]};
                const v4u pa = (v4u){pw[ks][0], pw[ks][1], pw[ks][2], pw[ks][3]};
                o[d0] = __builtin_amdgcn_mfma_f32_32x32x16_bf16(__builtin_bit_cast(bf16x8, pa), vf, o[d0], 0, 0, 0); }
        if (__all(F < FSTOP)) break;
        LDS_WAIT();
#pragma unroll
        for (int d0 = 0; d0 < 4; ++d0) { k0[d0] = k1[d0]; k1[d0] = k2[d0]; }
        if (j >= 3) { SB_KLD(k2, j - 3); SB_VDMA(j - 3, (slot + 3) & 3); }
    }
    VM_WAIT(); LDS_WAIT();
    { LAS bf16* stg = (LAS bf16*)wl;
      bf16* Ow = O + (rowbase + t0) * D + h * HD;
#pragma unroll
      for (int r = 0; r < 16; ++r) { const int orow = crow(r, hi);
#pragma unroll
          for (int d0 = 0; d0 < 2; ++d0) stg[orow * 64 + d0 * 32 + r32] = (bf16)(pk2(o[d0][r], 0.f) & 0xffffu); }
      LDS_WAIT();
#pragma unroll
      for (int i = 0; i < 4; ++i) { const int row = i * 8 + (lane >> 3), ch = lane & 7; const v4u v = *(const LAS v4u*)(stg + row * 64 + ch * 8); *(v4u*)(Ow + (long)row * D + ch * 8) = v; } }
    LDS_WAIT();
#undef SB_KLD
#undef SB_VDMA
}
__device__ __forceinline__ void attn_phase_v4(const bf16* Q, const bf16* K, const bf16* V, bf16* O, LAS unsigned char* lds, int vcu, int G) {
    int tid_ = threadIdx.x; asm volatile("" : "+v"(tid_)); const int lane = tid_ & 63, wid = __builtin_amdgcn_readfirstlane(tid_ >> 6);
    LAS unsigned char* wl = lds + wid * 16384;
    if (G == 256) {
        const int xb = vcu >> 5, lw = (vcu & 31) * NWAVES + wid;
        for (int i = 0; i < 4; ++i) { const int v = lw + 256 * i; attn_item4(xb, v & 15, 63 - (v >> 4), Q, K, V, O, wl, lane); }
    } else {
        const int NITEM = BATCH * NH * (SEQ / 32);
        for (int u = vcu * NWAVES + wid; u < NITEM; u += G * NWAVES) { const int bh = u & 127, qblk = 63 - (u >> 7); attn_item4(bh / NH, bh % NH, qblk, Q, K, V, O, wl, lane); }
    }
    __syncthreads();
}
}

#define XB_TMO      128
#define XB_XCNT(j)  (256  + 64 * (j))
#define XB_XSUB(j)  (1280 + 64 * (j))
#define XB_XGEN(j)  (2304 + 64 * (j))
#define XB_TOP      3328
#define XB_TOPGEN   3392
#define XCD_BAR_WORDS 3456
#define XB_SPIN_CAP (1u << 18)

__device__ __forceinline__ unsigned xb_ld(unsigned* p)              { return __hip_atomic_load(p, __ATOMIC_RELAXED, __HIP_MEMORY_SCOPE_AGENT); }
__device__ __forceinline__ unsigned xb_add(unsigned* p, unsigned v) { return __hip_atomic_fetch_add(p, v, __ATOMIC_RELAXED, __HIP_MEMORY_SCOPE_AGENT); }
__device__ __forceinline__ unsigned xb_xcc_id() { return (unsigned)__builtin_amdgcn_s_getreg((3 << 11) | 20) & 0xFu; }
#define XB_SPIN(cond, bar) do { unsigned _sp = 0; while (cond) { __builtin_amdgcn_s_sleep(1); \
    if ((++_sp & 255u) == 0u) { if (xb_ld(&(bar)[XB_TMO])) break; if (_sp > XB_SPIN_CAP) { atomicAdd(&(bar)[XB_TMO], 1u); break; } } } } while (0)

struct XcdBarrier {
    unsigned* bar; unsigned x;
    volatile LAS unsigned* st;
};

__device__ __forceinline__ XcdBarrier xcd_barrier_post(unsigned* bar, volatile LAS unsigned* st) {
    XcdBarrier b; b.bar = bar; b.x = xb_xcc_id(); b.st = st;
    if (threadIdx.x == 0) (void)xb_add(&bar[XB_XCNT(b.x)], 1u);
    return b;
}
__device__ __forceinline__ void xcd_barrier_complete(unsigned* bar, unsigned x, unsigned& nloc, unsigned& nx) {
    const unsigned G = gridDim.x * gridDim.y * gridDim.z;
    unsigned sum, cnt, mine, sp = 0u;
    for (;;) {
        sum = 0u; cnt = 0u; mine = 0u;
#pragma unroll
        for (unsigned j = 0; j < 16; ++j) { const unsigned c = xb_ld(&bar[XB_XCNT(j)]); sum += c; cnt += (c > 0u) ? 1u : 0u; mine = (j == x) ? c : mine; }
        if (sum == G) break;
        __builtin_amdgcn_s_sleep(1);
        if ((++sp & 255u) == 0u) { if (xb_ld(&bar[XB_TMO])) break; if (sp > XB_SPIN_CAP) { atomicAdd(&bar[XB_TMO], 1u); break; } }
    }
    nloc = mine > 0u ? mine : 1u; nx = cnt > 0u ? cnt : 1u;
}

__device__ __forceinline__ void xcd_barrier(const XcdBarrier& b) {
    asm volatile("s_waitcnt vmcnt(0)" ::: "memory");
    __syncthreads();
    if (threadIdx.x == 0) {
        unsigned* bar = b.bar;
        __builtin_amdgcn_s_waitcnt(0);
        unsigned nloc = b.st[0], nx = b.st[1];
        if (nloc == 0u) { xcd_barrier_complete(bar, b.x, nloc, nx); b.st[0] = nloc; b.st[1] = nx; }
        const unsigned old = xb_add(&bar[XB_XSUB(b.x)], 1u);
        const unsigned gen = old / nloc;
        if (old + 1u == (gen + 1u) * nloc) {
            __builtin_amdgcn_fence(__ATOMIC_RELEASE, "agent");
            asm volatile("s_waitcnt vmcnt(0)" ::: "memory");
            const unsigned og = xb_add(&bar[XB_TOP], 1u);
            const unsigned tg = og / nx;
            if (og + 1u == (tg + 1u) * nx) xb_add(&bar[XB_TOPGEN], 1u);
            else XB_SPIN(xb_ld(&bar[XB_TOPGEN]) == tg, bar);
            __builtin_amdgcn_fence(__ATOMIC_ACQUIRE, "agent");
            xb_add(&bar[XB_XGEN(b.x)], 1u);
            asm volatile("s_waitcnt vmcnt(0)" ::: "memory");
        } else {
            XB_SPIN(xb_ld(&bar[XB_XGEN(b.x)]) == gen, bar);
            __builtin_amdgcn_fence(__ATOMIC_ACQUIRE, "agent");
            asm volatile("s_waitcnt vmcnt(0)" ::: "memory");
        }
    }
    __syncthreads();
}

__global__ void __launch_bounds__(NTHR, 2) mk_fwd(Args a) {
    extern __shared__ __attribute__((aligned(16))) unsigned char lds_raw[];
    cg::grid_group grid = cg::this_grid();
    LAS unsigned char* lds = (LAS unsigned char*)lds_raw;
    const int tid = threadIdx.x, lane = tid & 63, wave = __builtin_amdgcn_readfirstlane(tid >> 6);
    const int G = gridDim.x, bx = blockIdx.x; const int vcu = (G % 8 == 0) ? (bx % 8) * (G / 8) + bx / 8 : bx;
    unsigned char* ws = a.ws;
    float* ss = (float*)(ws + WS_SS); bf16* hb = (bf16*)(ws + WS_HB); bf16* KB = (bf16*)(ws + WS_K); bf16* VB = (bf16*)(ws + WS_V);
    bf16* ACT = (bf16*)(ws + WS_ACT); bf16* B0 = ACT; bf16* B1 = (bf16*)(ws + WS_ACT + 32 * MiB);
    float* h = a.out;
    volatile LAS unsigned* xst = (volatile LAS unsigned*)(lds + LDS_BYTES - 64);
    if (tid < 4) xst[tid] = 0u;
    __syncthreads();
    XcdBarrier xbar = xcd_barrier_post((unsigned*)ws, xst);

#ifndef DBG_STOP
#define DBG_STOP 0
#endif
#ifndef DBG_SRC
#define DBG_SRC 5
#endif
    int nsync = 0;
#ifdef DUP_SYNC
#define DUP_SYNC_BODY xcd_barrier(xbar);
#else
#define DUP_SYNC_BODY
#endif
#define GRID_SYNC() do { xcd_barrier(xbar); \
        DUP_SYNC_BODY \
        if (DBG_STOP && ++nsync == DBG_STOP) { const bf16* src_ = DBG_SRC == 0 ? hb : DBG_SRC == 1 ? B0 : DBG_SRC == 2 ? B1 : DBG_SRC == 3 ? KB : VB; \
            for (size_t i_ = (size_t)bx * NTHR + tid; i_ < (size_t)M * D; i_ += (size_t)G * NTHR) { float v_ = __uint_as_float((unsigned)((DBG_SRC == 5) ? hb[i_] : src_[i_]) << 16); if (!(__builtin_fabsf(v_) < 1e30f)) v_ = 12345.0f; h[i_] = v_; } return; } } while (0)
#ifdef DUP_PRO
    prologue_phase(a, lds, vcu, G, wave, lane); __syncthreads();
#endif
    prologue_phase(a, lds, vcu, G, wave, lane);
    GRID_SYNC();

#ifndef GEMM_SP2
#define GEMM_SP2 true
#endif
#ifndef GEMM_ALIGN
#define GEMM_ALIGN true
#endif
#define GEMM(EpiT, Aptr, Bptr, N_, K_, epi) do { pg8::Gemm g_{(const bf16*)(Aptr), (const bf16*)(Bptr), M, (N_), (K_)}; pg8::StaticOrder S_; S_.init(M, (N_), G, bx); \
        pg8::gemm_phase<EpiT, pg8::StaticOrder, GEMM_ALIGN, GEMM_SP2>(lds, g_, S_, epi); } while (0)

    for (int l = 0; l < 4; ++l) {
        for (int which = 0; which < 2; ++which) {
            const int f = 2 * l + which;
            if (which == 1) {
                if (l < 2) {
                    { pg8::EpiGated<1> E{B0, D, ss + (3 * l + 1) * SSM, a.in[I_BPW1] + l * 2 * D, a.in[I_BPW1] + l * 2 * D + D}; GEMM(pg8::EpiGated<1>, hb, ws + WS_WX + (size_t)l * 4 * MiB, 2 * D, D, E); }
                    GRID_SYNC();
#ifdef DUP_DW
                    dwconv_phase(B0, B1, a.in[I_WDW] + l * CW * D, a.in[I_BDW] + l * D, a.in[I_LNG] + l * D, a.in[I_LNB] + l * D, lds, vcu, G);
#endif
                    dwconv_phase(B0, B1, a.in[I_WDW] + l * CW * D, a.in[I_BDW] + l * D, a.in[I_LNG] + l * D, a.in[I_LNB] + l * D, lds, vcu, G);
                    GRID_SYNC();
                    { pg8::EpiResid E{hb, ss + (3 * l + 2) * SSM, a.in[I_BPW2] + l * D, 1.0f}; GEMM(pg8::EpiResid, B1, ws + WS_WX + (12 + 2 * l) * MiB, D, D, E); }
                    GRID_SYNC();
                } else {
                    const int i = l - 2;
                    { pg8::EpiScaleBf16 E{B0, D, ss + (3 * l + 1) * SSM, 0, 0, 0.125f * pg8::LOG2E}; GEMM(pg8::EpiScaleBf16, hb, ws + WS_WX + (16 + 2 * i) * MiB, D, D, E); }
                    GRID_SYNC();
#ifdef DUP_ATT
                    sba::attn_phase_v4(B0, KB, VB, B1, lds, vcu, G);
#endif
                    sba::attn_phase_v4(B0, KB, VB, B1, lds, vcu, G);
                    GRID_SYNC();
                    { pg8::EpiResid E{hb, ss + (3 * l + 2) * SSM, nullptr, 1.0f}; GEMM(pg8::EpiResid, B1, ws + WS_WX + (20 + 2 * i) * MiB, D, D, E); }
                    GRID_SYNC();
                }
            }
            const int si = 3 * l + (which ? 2 : 0);
#ifdef DUP_GU
            { pg8::EpiGated<0> E{ACT, (a.ws != nullptr) ? -FF : FF, ss + si * SSM, nullptr, nullptr}; GEMM(pg8::EpiGated<0>, hb, ws + WS_W + (size_t)f * W_FFN_STRIDE, 2 * FF, D, E); }
#endif
            { pg8::EpiGated<0> E{ACT, FF, ss + si * SSM, nullptr, nullptr}; GEMM(pg8::EpiGated<0>, hb, ws + WS_W + (size_t)f * W_FFN_STRIDE, 2 * FF, D, E); }
            if (l == 2 && which == 0) {
                pg8::EpiScaleBf16 E{KB, D, ss + si * SSM, D, (size_t)(WS_V - WS_K) / 2, 1.0f}; GEMM(pg8::EpiScaleBf16, hb, ws + WS_WX + 8 * MiB, 2 * D, D, E);
            }
            if (G == 256) {
                if (bx >= 128) { if (f < 7) convert_ffn(a, f + 1, lds, (bx - 128) * NWAVES + wave, 128 * NWAVES, wave, lane); if (f < 4) convert_small(a, f, lds, 1023 - ((bx - 128) * NWAVES + wave), 128 * NWAVES, wave, lane); }
            } else {
                if (f < 7) convert_ffn(a, f + 1, lds, bx * NWAVES + wave, G * NWAVES, wave, lane); if (f < 4) convert_small(a, f, lds, bx * NWAVES + wave, G * NWAVES, wave, lane);
            }
            GRID_SYNC();
#ifdef DUP_DOWN
            if (f > 0)             { pg8::EpiResid E{hb, ss + (si + 1) * SSM, nullptr, 0.0f}; GEMM(pg8::EpiResid, ACT, ws + WS_W + (size_t)f * W_FFN_STRIDE + W_FFN_DOWN, D, FF, E); }
#endif
            { pg8::EpiResid E{hb, ss + (si + 1) * SSM, nullptr, 0.5f}; GEMM(pg8::EpiResid, ACT, ws + WS_W + (size_t)f * W_FFN_STRIDE + W_FFN_DOWN, D, FF, E); }
            GRID_SYNC();
        }
    }
    final_phase(a.out, hb, ss + 12 * SSM, a.in[I_FINN], vcu, G, wave, lane);
    asm volatile("s_waitcnt vmcnt(0)" ::: "memory"); __syncthreads(); grid.sync();
}

extern "C" void kernel_launch(void* const* d_in, const int* in_sizes, int n_in, void* d_out, int out_size, void* d_ws, size_t ws_size, hipStream_t stream) {
    static int grid = 0;
    if (grid == 0) {
        if (n_in != 23 || in_sizes[0] != M * D || out_size != M * D || ws_size < WS_END) { fprintf(stderr, "kernel_launch: unexpected shapes (n_in %d, in0 %d, out %d, ws %zu < %zu)\n", n_in, n_in > 0 ? in_sizes[0] : -1, out_size, ws_size, (size_t)WS_END); grid = -1; return; }
        int dev = 0, cus = 0, per_cu = 0;
        if (hipGetDevice(&dev) != hipSuccess || hipDeviceGetAttribute(&cus, hipDeviceAttributeMultiprocessorCount, dev) != hipSuccess) { grid = -1; return; }
        if (hipFuncSetAttribute((const void*)mk_fwd, hipFuncAttributeMaxDynamicSharedMemorySize, LDS_BYTES) != hipSuccess) { fprintf(stderr, "kernel_launch: hipFuncSetAttribute failed\n"); grid = -1; return; }
        if (hipOccupancyMaxActiveBlocksPerMultiprocessor(&per_cu, (const void*)mk_fwd, NTHR, LDS_BYTES) != hipSuccess || per_cu < 1) { fprintf(stderr, "kernel_launch: occupancy query says %d\n", per_cu); per_cu = 1; }
        (void)hipGetLastError();
        grid = cus;
    }
    if (grid < 0) return;
    if (hipMemsetAsync(d_ws, 0, 16384, stream) != hipSuccess) { fprintf(stderr, "kernel_launch: hipMemsetAsync failed\n"); return; }
    Args a{};
    for (int i = 0; i < 23; ++i) a.in[i] = (const float*)d_in[i];
    a.out = (float*)d_out; a.ws = (unsigned char*)d_ws;
    void* args[] = {&a};
    hipError_t e = hipLaunchCooperativeKernel((const void*)mk_fwd, dim3(grid), dim3(NTHR), args, LDS_BYTES, stream);
    if (e != hipSuccess) fprintf(stderr, "cooperative launch failed: %s (grid %d)\n", hipGetErrorString(e), grid);
}
```

```cpp
#include <hip/hip_runtime.h>
#include <hip/hip_cooperative_groups.h>
#include <cstdio>
#include <cstdint>
namespace cg = cooperative_groups;
#ifndef PG8_WGM
#define PG8_WGM 8
#endif
namespace pg8 {
#define PG8_LAS __attribute__((address_space(3)))
typedef unsigned short bf16_t;
typedef short bf16x8 __attribute__((ext_vector_type(8)));
typedef float f32x4 __attribute__((ext_vector_type(4)));
typedef unsigned u32x4 __attribute__((ext_vector_type(4)));
constexpr int BM = 256, BK = 64, HALF = 128, HTB = HALF * BK * 2  , STAGE_BYTES = 8 * HTB, NXCD = 8, WGM = PG8_WGM;

__host__ __device__ __forceinline__ int lds_byte(int r, int c) { const int st = (r >> 4) * 2 + (c >> 5), rr = r & 15, cc = c & 31, ob = rr * 64 + cc * 2; return st * 1024 + (ob ^ (((ob >> 9) & 1) << 5)); }
__host__ __device__ __forceinline__ void stage_rc(int b, int& R, int& C) { const int st = b / 1024, sb = b % 1024, swz = sb ^ (((sb >> 9) & 1) << 5); R = (st >> 1) * 16 + swz / 64; C = (st & 1) * 32 + (swz % 64) / 2; }
__host__ __device__ __forceinline__ int perm32(int rho) { const int n = rho >> 4, i = rho & 15; return 8 * (i >> 2) + 4 * n + (i & 3); }

struct Unit { int pm, pn; };
struct Gemm { const bf16_t* A; const bf16_t* Bt; int M, N, K; };

struct StaticOrder {
    int nM, nN, nwg, G, c;
    __host__ __device__ void init(int M, int N, int G_, int c_) { nM = M / BM; nN = N / BM; nwg = nM * nN; G = G_; c = c_; }
    __host__ __device__ bool next(int i, Unit& u) const {
        const long L = (long)i * G + c; if (L >= nwg) return false;
        int wgid = (int)L; { const int q = nwg / NXCD, r = nwg % NXCD, xcd = wgid % NXCD, off = wgid / NXCD; wgid = (xcd < r ? xcd * (q + 1) : r * (q + 1) + (xcd - r) * q) + off; }
        const int nig = WGM * nN, gid = wgid / nig, fm = gid * WGM, gsz = (nM - fm) < WGM ? (nM - fm) : WGM;
        u.pm = fm + ((wgid % nig) % gsz); u.pn = (wgid % nig) / gsz; return true;
    }
    __device__ __forceinline__ void a_ready(const Unit&) const {}
    __device__ __forceinline__ void done(const Unit&) const {}
};

__device__ __forceinline__ unsigned cvt_pk_bf16(float lo, float hi) { unsigned r; asm volatile("v_cvt_pk_bf16_f32 %0, %1, %2" : "=v"(r) : "v"(lo), "v"(hi)); return r; }
typedef float f32x2 __attribute__((ext_vector_type(2)));

constexpr float RMS_EPS_F = 1e-6f, INV_D = 1.0f / 1024.0f, LOG2E = 1.4426950408889634f;
__device__ __forceinline__ float row_rstd(const float* ss, int row, int fq) { const f32x4 v = *(const f32x4*)(ss + (size_t)row * 16 + 4 * fq); float s = (v[0] + v[1]) + (v[2] + v[3]); s += __shfl_xor(s, 16); s += __shfl_xor(s, 32); return __builtin_amdgcn_rsqf(s * INV_D + RMS_EPS_F); }
__device__ __forceinline__ void row_rstd8(float (&rs)[8], const float* ss, int row0, int fq) {
    f32x4 v[8];
#pragma unroll
    for (int i = 0; i < 8; ++i) v[i] = *(const f32x4*)(ss + (size_t)(row0 + (i >> 2) * HALF + (i & 3) * 16) * 16 + 4 * fq);
#pragma unroll
    for (int i = 0; i < 8; ++i) { float s = (v[i][0] + v[i][1]) + (v[i][2] + v[i][3]); s += __shfl_xor(s, 16); s += __shfl_xor(s, 32); rs[i] = __builtin_amdgcn_rsqf(s * INV_D + RMS_EPS_F); }
}
#ifndef EPI_WT
#define EPI_WT 0
#endif
__device__ __forceinline__ void st16(bf16_t* p, u32x4 w) {
#if EPI_WT
    unsigned long long* q = (unsigned long long*)p;
    __hip_atomic_store(q, (unsigned long long)w.x | ((unsigned long long)w.y << 32), __ATOMIC_RELAXED, __HIP_MEMORY_SCOPE_AGENT);
    __hip_atomic_store(q + 1, (unsigned long long)w.z | ((unsigned long long)w.w << 32), __ATOMIC_RELAXED, __HIP_MEMORY_SCOPE_AGENT);
#else
    *(u32x4*)p = w;
#endif
}
__device__ __forceinline__ float fast_sigmoid(float g) { return __builtin_amdgcn_rcpf(1.0f + __builtin_amdgcn_exp2f(-g * LOG2E)); }

template <int MODE> struct EpiGated {
    static constexpr bool PERM = true, AFTER_DRAIN = false;
    bf16_t* O; int ldc; const float* ss; const float* b0; const float* b1;
    __device__ __forceinline__ void operator()(const f32x4 (&acc)[2][2][4][2], const Unit& u, int wr, int wc, int fr, int fq) const {
#ifdef DUP_GU
        if (ldc < 0) return;
#endif
        const int row0 = u.pm * BM + wr * 64 + fr; const int col0 = u.pn * HALF + wc * 32 + 8 * fq;
        f32x4 bv0[2], bv1[2];
#pragma unroll
        for (int n = 0; n < 2; ++n) { bv0[n] = (MODE == 1) ? *(const f32x4*)(b0 + col0 + 4 * n) : (f32x4){0.f, 0.f, 0.f, 0.f}; bv1[n] = (MODE == 1) ? *(const f32x4*)(b1 + col0 + 4 * n) : (f32x4){0.f, 0.f, 0.f, 0.f}; }
        float rs8[8]; row_rstd8(rs8, ss, row0, fq);
#pragma unroll
        for (int ai = 0; ai < 2; ++ai)
#pragma unroll
            for (int m = 0; m < 4; ++m) { const int row = row0 + ai * HALF + m * 16; const float rstd = rs8[ai * 4 + m];
                u32x4 w; unsigned wv[4];
#pragma unroll
                for (int n = 0; n < 2; ++n) { f32x4 a = acc[ai][0][m][n] * rstd + bv0[n], g = acc[ai][1][m][n] * rstd + bv1[n]; f32x4 o;
#pragma unroll
                    for (int e = 0; e < 4; ++e) { if (MODE == 0) o[e] = a[e] * fast_sigmoid(a[e]) * g[e]; else o[e] = a[e] * fast_sigmoid(g[e]); }
                    wv[2 * n] = cvt_pk_bf16(o[0], o[1]); wv[2 * n + 1] = cvt_pk_bf16(o[2], o[3]); }
                w.x = wv[0]; w.y = wv[1]; w.z = wv[2]; w.w = wv[3];
                st16(O + (size_t)row * ldc + col0, w); }
    }
};
struct EpiScaleBf16 {
    static constexpr bool PERM = true, AFTER_DRAIN = false;
    bf16_t* O; int ldc; const float* ss; int split_cols; size_t split_stride; float sc;
    __device__ __forceinline__ void operator()(const f32x4 (&acc)[2][2][4][2], const Unit& u, int wr, int wc, int fr, int fq) const {
        const int row0 = u.pm * BM + wr * 64 + fr; int colt = u.pn * BM; bf16_t* base = O;
        if (split_cols) { const int t = colt / split_cols; base += (size_t)t * split_stride; colt -= t * split_cols; }
        const int col0 = colt + wc * 32 + 8 * fq;
        float rs8[8]; row_rstd8(rs8, ss, row0, fq);
#pragma unroll
        for (int ai = 0; ai < 2; ++ai)
#pragma unroll
            for (int m = 0; m < 4; ++m) { const int row = row0 + ai * HALF + m * 16; const float rs = rs8[ai * 4 + m] * sc;
                bf16_t* rowp = base + (size_t)row * ldc + col0;
#pragma unroll
                for (int bj = 0; bj < 2; ++bj) { const f32x4 v0 = acc[ai][bj][m][0] * rs, v1 = acc[ai][bj][m][1] * rs;
                    u32x4 w; w.x = cvt_pk_bf16(v0[0], v0[1]); w.y = cvt_pk_bf16(v0[2], v0[3]); w.z = cvt_pk_bf16(v1[0], v1[1]); w.w = cvt_pk_bf16(v1[2], v1[3]);
                    st16(rowp + bj * HALF, w); } }
    }
};
__device__ __forceinline__ float bf_lo(unsigned w) { return __uint_as_float(w << 16); }
__device__ __forceinline__ float bf_hi(unsigned w) { return __uint_as_float(w & 0xffff0000u); }
struct EpiResid {
    static constexpr bool PERM = true, AFTER_DRAIN = false;
    bf16_t* hb; float* ssn; const float* bias; float alpha;
    __device__ __forceinline__ void operator()(const f32x4 (&acc)[2][2][4][2], const Unit& u, int wr, int wc, int fr, int fq) const {
#ifdef DUP_DOWN
        if (alpha == 0.0f) return;
#endif
        const int row0 = u.pm * BM + wr * 64 + fr; const int col0 = u.pn * BM + wc * 32 + 8 * fq;
        f32x4 bv[2][2];
#pragma unroll
        for (int bj = 0; bj < 2; ++bj)
#pragma unroll
            for (int n = 0; n < 2; ++n) bv[bj][n] = bias ? *(const f32x4*)(bias + col0 + bj * HALF + 4 * n) : (f32x4){0.f, 0.f, 0.f, 0.f};
        u32x4 pre[3][2];
#define RES_LOAD(it_) do { const size_t off_ = (size_t)(row0 + ((it_) >> 2) * HALF + ((it_) & 3) * 16) * 1024 + col0; \
            _Pragma("unroll") for (int bj = 0; bj < 2; ++bj) pre[(it_) % 3][bj] = *(const u32x4*)(hb + off_ + bj * HALF); } while (0)
        RES_LOAD(0); RES_LOAD(1); RES_LOAD(2);
#pragma unroll
        for (int it = 0; it < 8; ++it) { const int ai = it >> 2, m = it & 3; const int row = row0 + ai * HALF + m * 16; const size_t off = (size_t)row * 1024 + col0; float s = 0.f;
            u32x4 w[2];
#pragma unroll
            for (int bj = 0; bj < 2; ++bj) { const u32x4 hw = pre[it % 3][bj];
                const f32x4 h0 = (f32x4){bf_lo(hw.x), bf_hi(hw.x), bf_lo(hw.y), bf_hi(hw.y)}, h1 = (f32x4){bf_lo(hw.z), bf_hi(hw.z), bf_lo(hw.w), bf_hi(hw.w)};
                const f32x4 o0 = h0 + (acc[ai][bj][m][0] + bv[bj][0]) * alpha, o1 = h1 + (acc[ai][bj][m][1] + bv[bj][1]) * alpha;
                w[bj].x = cvt_pk_bf16(o0[0], o0[1]); w[bj].y = cvt_pk_bf16(o0[2], o0[3]); w[bj].z = cvt_pk_bf16(o1[0], o1[1]); w[bj].w = cvt_pk_bf16(o1[2], o1[3]);
                s += ((o0[0] * o0[0] + o0[1] * o0[1]) + (o0[2] * o0[2] + o0[3] * o0[3])) + ((o1[0] * o1[0] + o1[1] * o1[1]) + (o1[2] * o1[2] + o1[3] * o1[3])); }
            if (it + 3 < 8) RES_LOAD(it + 3);
#pragma unroll
            for (int bj = 0; bj < 2; ++bj) st16(hb + off + bj * HALF, w[bj]);
            s += __shfl_xor(s, 16); s += __shfl_xor(s, 32);
            if (fq == 0) ssn[(size_t)row * 16 + u.pn * 4 + wc] = s; }
#undef RES_LOAD
    }
};
#ifndef PG8_AUXA
#define PG8_AUXA 0
#endif
#ifndef PG8_AUXB
#define PG8_AUXB 0
#endif
template <class Epi, class Sched, bool ALIGN_EPI = false, bool SP2 = false>
__device__ __forceinline__ void gemm_phase(PG8_LAS unsigned char* lds, const Gemm g, const Sched& S, const Epi& E) {
    int tid_ = threadIdx.x; asm volatile("" : "+v"(tid_)); const int tid = tid_, wid = __builtin_amdgcn_readfirstlane(tid >> 6), lane = tid & 63, wr = wid >> 2, wc = wid & 3, fr = lane & 15, fq = lane >> 4;
    const int K = g.K, nt = K / BK;
    unsigned voffA[2], voffB[2];
#pragma unroll
    for (int i = 0; i < 2; ++i) { int R, C; stage_rc(tid * 16 + i * 8192, R, C); const int Rb = Epi::PERM ? ((R & ~31) + perm32(R & 31)) : R;
        voffA[i] = (unsigned)(R * K + C) * 2u; voffB[i] = (unsigned)(Rb * K + C) * 2u; }
    const size_t kstep = (size_t)(BK * 2);
    const size_t hstep = (size_t)HALF * K * 2;
    const size_t tstep = 2 * hstep;
    const unsigned ldsw = (unsigned)wid * 1024u;
    const int aoff = lds_byte(wr * 64 + fr, fq * 8), boff = lds_byte(wc * 32 + fr, fq * 8);
#define PG8_SA(b, h) (((b) * 2 + (h)) * HTB)
#define PG8_SB(b, h) ((4 + (b) * 2 + (h)) * HTB)
#define PG8_STAGE(bufoff, gbase, voff) do { _Pragma("unroll") for (int _i = 0; _i < 2; ++_i) \
        __builtin_amdgcn_global_load_lds((const unsigned*)((const char*)(gbase) + (voff)[_i]), (PG8_LAS unsigned*)(lds + (bufoff) + ldsw + _i * 8192), 16, 0, ((bufoff) >= 4 * HTB) ? PG8_AUXB : PG8_AUXA); } while (0)
#define PG8_LDA(dst, b, h) do { _Pragma("unroll") for (int m = 0; m < 4; ++m) _Pragma("unroll") for (int k = 0; k < 2; ++k) dst[m][k] = *(const PG8_LAS bf16x8*)(lds + PG8_SA(b, h) + aoff + m * 2048 + k * 1024); } while (0)
#define PG8_LDB(dst, b, h) do { _Pragma("unroll") for (int n = 0; n < 2; ++n) _Pragma("unroll") for (int k = 0; k < 2; ++k) dst[n][k] = *(const PG8_LAS bf16x8*)(lds + PG8_SB(b, h) + boff + n * 2048 + k * 1024); } while (0)
#define PG8_MMA(ai, bj, At, Bt) do { __builtin_amdgcn_s_setprio(1); _Pragma("unroll") for (int m = 0; m < 4; ++m) _Pragma("unroll") for (int n = 0; n < 2; ++n) _Pragma("unroll") for (int k = 0; k < 2; ++k) \
        acc[ai][bj][m][n] = __builtin_amdgcn_mfma_f32_16x16x32_bf16(Bt[n][k], At[m][k], acc[ai][bj][m][n], 0, 0, 0); __builtin_amdgcn_s_setprio(0); } while (0)
#define PG8_WAIT_V(n) asm volatile("s_waitcnt vmcnt(" #n ")" ::: "memory")
#define PG8_WAIT_L(n) asm volatile("s_waitcnt lgkmcnt(" #n ")" ::: "memory")
#define PG8_BAR __builtin_amdgcn_s_barrier()
#define PG8_SCHED __builtin_amdgcn_sched_barrier(0)
    Unit cur, nxt; int ui = 0;
    if (!S.next(0, cur)) return;
    f32x4 acc[2][2][4][2];
#pragma unroll
    for (int a = 0; a < 2; ++a)
#pragma unroll
        for (int b = 0; b < 2; ++b)
#pragma unroll
            for (int m = 0; m < 4; ++m)
#pragma unroll
                for (int n = 0; n < 2; ++n) acc[a][b][m][n] = (f32x4){0.f, 0.f, 0.f, 0.f};
    bf16x8 At[4][2], B0[2][2], B1[2][2];
    const char* cA = (const char*)g.A + (size_t)cur.pm * tstep; const char* cB = (const char*)g.Bt + (size_t)cur.pn * tstep;
    S.a_ready(cur);
    if constexpr (SP2) {
        PG8_STAGE(PG8_SB(0, 0), cB, voffB); PG8_STAGE(PG8_SB(0, 1), cB + hstep, voffB); PG8_STAGE(PG8_SA(0, 0), cA, voffA); PG8_STAGE(PG8_SA(0, 1), cA + hstep, voffA);
        if (wr == 1) PG8_BAR;
        PG8_WAIT_V(2); PG8_BAR;
        PG8_STAGE(PG8_SB(1, 0), cB + kstep, voffB); PG8_STAGE(PG8_SA(1, 0), cA + kstep, voffA); PG8_STAGE(PG8_SB(1, 1), cB + hstep + kstep, voffB);
        PG8_WAIT_V(6); PG8_BAR;
    } else {
        PG8_STAGE(PG8_SB(0, 0), cB, voffB); PG8_STAGE(PG8_SA(0, 0), cA, voffA); PG8_STAGE(PG8_SB(0, 1), cB + hstep, voffB); PG8_STAGE(PG8_SA(0, 1), cA + hstep, voffA);
        if (wr == 1) PG8_BAR;
        PG8_WAIT_V(4); PG8_BAR;
        PG8_STAGE(PG8_SB(1, 0), cB + kstep, voffB); PG8_STAGE(PG8_SA(1, 0), cA + kstep, voffA); PG8_STAGE(PG8_SB(1, 1), cB + hstep + kstep, voffB);
        PG8_WAIT_V(6); PG8_BAR;
    }
    for (;;) {
        const bool has_next = S.next(ui + 1, nxt);
        const char* nA = has_next ? (const char*)g.A + (size_t)nxt.pm * tstep : cA; const char* nB = has_next ? (const char*)g.Bt + (size_t)nxt.pn * tstep : cB;
        for (int t = 0; t < nt; t += 2) {
            const bool last = (t == nt - 2);
            const char* a1 = cA + (size_t)(t + 1) * kstep;
            const char* a2 = last ? nA : cA + (size_t)(t + 2) * kstep; const char* b2 = last ? nB : cB + (size_t)(t + 2) * kstep;
            const char* a3 = a2 + kstep; const char* b3 = b2 + kstep;
            if (last && has_next) S.a_ready(nxt);
            if constexpr (SP2) {
            PG8_LDB(B0, 0, 0); PG8_LDB(B1, 0, 1); PG8_SCHED; PG8_LDA(At, 0, 0); PG8_STAGE(PG8_SA(1, 1), a1 + hstep, voffA);
            PG8_WAIT_V(8); PG8_WAIT_L(0); PG8_BAR; PG8_MMA(0, 0, At, B0); PG8_MMA(0, 1, At, B1); PG8_BAR; PG8_SCHED;
            PG8_LDA(At, 0, 1); PG8_STAGE(PG8_SB(0, 0), b2, voffB); PG8_STAGE(PG8_SB(0, 1), b2 + hstep, voffB); PG8_STAGE(PG8_SA(0, 0), a2, voffA);
            PG8_WAIT_V(8); PG8_WAIT_L(0); PG8_BAR; PG8_MMA(1, 0, At, B0); PG8_MMA(1, 1, At, B1); PG8_BAR; PG8_SCHED;
            PG8_LDB(B0, 1, 0); PG8_LDB(B1, 1, 1); PG8_SCHED; PG8_LDA(At, 1, 0); PG8_STAGE(PG8_SA(0, 1), a2 + hstep, voffA);
            PG8_WAIT_V(8); PG8_WAIT_L(0); PG8_BAR; PG8_MMA(0, 0, At, B0); PG8_MMA(0, 1, At, B1); PG8_BAR; PG8_SCHED;
            PG8_LDA(At, 1, 1); PG8_STAGE(PG8_SB(1, 0), b3, voffB); PG8_STAGE(PG8_SB(1, 1), b3 + hstep, voffB); PG8_STAGE(PG8_SA(1, 0), a3, voffA);
            PG8_WAIT_V(8); PG8_WAIT_L(0); PG8_BAR; PG8_MMA(1, 0, At, B0); PG8_MMA(1, 1, At, B1); PG8_BAR; PG8_SCHED;
            } else {
            PG8_LDB(B0, 0, 0); PG8_SCHED; PG8_LDA(At, 0, 0); PG8_STAGE(PG8_SA(1, 1), a1 + hstep, voffA);
            PG8_WAIT_L(8); PG8_BAR; PG8_WAIT_L(0); PG8_MMA(0, 0, At, B0); PG8_BAR; PG8_SCHED;
            PG8_LDB(B1, 0, 1); PG8_STAGE(PG8_SB(0, 0), b2, voffB);
            PG8_BAR; PG8_WAIT_L(0); PG8_MMA(0, 1, At, B1); PG8_BAR;
            PG8_LDA(At, 0, 1); PG8_STAGE(PG8_SA(0, 0), a2, voffA);
            PG8_BAR; PG8_WAIT_L(0); PG8_MMA(1, 0, At, B0); PG8_BAR; PG8_SCHED;
            PG8_STAGE(PG8_SB(0, 1), b2 + hstep, voffB);
            PG8_WAIT_V(6); PG8_BAR; PG8_MMA(1, 1, At, B1); PG8_BAR;
            PG8_LDB(B0, 1, 0); PG8_SCHED; PG8_LDA(At, 1, 0); PG8_STAGE(PG8_SA(0, 1), a2 + hstep, voffA);
            PG8_WAIT_L(8); PG8_BAR; PG8_WAIT_L(0); PG8_MMA(0, 0, At, B0); PG8_BAR; PG8_SCHED;
            PG8_LDB(B1, 1, 1); PG8_STAGE(PG8_SB(1, 0), b3, voffB);
            PG8_BAR; PG8_WAIT_L(0); PG8_MMA(0, 1, At, B1); PG8_BAR;
            PG8_LDA(At, 1, 1); PG8_STAGE(PG8_SA(1, 0), a3, voffA);
            PG8_BAR; PG8_WAIT_L(0); PG8_MMA(1, 0, At, B0); PG8_BAR; PG8_SCHED;
            PG8_STAGE(PG8_SB(1, 1), b3 + hstep, voffB);
            PG8_WAIT_V(6); PG8_BAR; PG8_MMA(1, 1, At, B1); PG8_BAR;
            }
        }
        if constexpr (ALIGN_EPI) { if (wr == 0) PG8_BAR; }
        if constexpr (!Epi::AFTER_DRAIN) { E(acc, cur, wr, wc, fr, fq); S.done(cur); }
        if (!has_next) break;
#pragma unroll
        for (int a = 0; a < 2; ++a)
#pragma unroll
            for (int b = 0; b < 2; ++b)
#pragma unroll
                for (int m = 0; m < 4; ++m)
#pragma unroll
                    for (int n = 0; n < 2; ++n) acc[a][b][m][n] = (f32x4){0.f, 0.f, 0.f, 0.f};
        cur = nxt; cA = nA; cB = nB; ++ui;
        if constexpr (ALIGN_EPI) { if (wr == 1) PG8_BAR; }
    }
    PG8_WAIT_V(0);
    if constexpr (!ALIGN_EPI) { if (wr == 0) PG8_BAR; }
    PG8_BAR;
    if constexpr (Epi::AFTER_DRAIN) { E.fused(acc, cur, wr, wc, fr, fq, lds, wid, lane); S.done(cur); }
#undef PG8_SA
#undef PG8_SB
#undef PG8_STAGE
#undef PG8_LDA
#undef PG8_LDB
#undef PG8_MMA
#undef PG8_WAIT_V
#undef PG8_WAIT_L
#undef PG8_BAR
#undef PG8_SCHED
}
}

constexpr int NWAVES = 8, NTHR = 512;
constexpr int BATCH = 8, SEQ = 2048, D = 1024, FF = 2816, NH = 16, HD = 64, CW = 31;
constexpr int M = BATCH * SEQ;
constexpr size_t MiB = 1u << 20;
constexpr size_t WS_SS = 344 * MiB;
constexpr size_t WS_HB = 2 * MiB;
constexpr size_t WS_K = 34 * MiB, WS_V = 66 * MiB;
constexpr size_t WS_ACT = 98 * MiB;
constexpr size_t WS_W = 186 * MiB;
constexpr size_t W_FFN_STRIDE = 16 * MiB + MiB / 2, W_FFN_DOWN = 11 * MiB;
constexpr size_t WS_WX = WS_W + 8 * W_FFN_STRIDE;
constexpr size_t WS_END = WS_SS + 13 * MiB;
constexpr int SSM = M * 16;
constexpr int NSS = 13;
constexpr int LDS_BYTES = 147456;

#define GAS __attribute__((address_space(1)))
#define LAS __attribute__((address_space(3)))
typedef unsigned short bf16;
typedef unsigned v4u __attribute__((ext_vector_type(4)));
typedef float f32x4 __attribute__((ext_vector_type(4)));
typedef float f32x2 __attribute__((ext_vector_type(2)));
typedef short bf16x8 __attribute__((ext_vector_type(8)));
#define LDS_WAIT() asm volatile("s_waitcnt lgkmcnt(0)" ::: "memory")
#define VM_WAIT() asm volatile("s_waitcnt vmcnt(0)" ::: "memory")
typedef __bf16 bf16x2_t __attribute__((ext_vector_type(2)));
__device__ __forceinline__ unsigned pk2(float lo, float hi) { f32x2 v = {lo, hi}; bf16x2_t b = __builtin_convertvector(v, bf16x2_t); return __builtin_bit_cast(unsigned, b); }
__device__ __forceinline__ float wave_sum(float v) {
#pragma unroll
    for (int o = 1; o < 64; o <<= 1) v += __shfl_xor(v, o);
    return v;
}

struct Args { const float* in[23]; float* out; unsigned char* ws; };
enum { I_X = 0, I_F1N, I_F1G, I_F1U, I_F1D, I_MIXN, I_F2N, I_F2G, I_F2U, I_F2D, I_PW1, I_BPW1, I_WDW, I_BDW, I_LNG, I_LNB, I_PW2, I_BPW2, I_KVN, I_WKV, I_WQ, I_WO, I_FINN };

__device__ __forceinline__ void xpose_item(const float* W, int K, int N, const float* gain, bf16* WT, int mode, LAS float* scr, int item, int lane) {
    const int nblk = N / 64, kb = item / nblk, nb = item % nblk, k0 = 64 * kb, n0 = 64 * nb;
    int d0 = n0;
    if (mode == 1) d0 = 256 * (n0 >> 7) + (n0 & 127);
    else if (mode == 2) d0 = 256 * (n0 >> 7) + 128 + (n0 & 127);
    else if (mode == 3) { const int nn = n0 & 1023; d0 = 256 * (nn >> 7) + 128 * (n0 >> 10) + (nn & 127); }
    const float* src = W + (size_t)k0 * N + n0 + lane;
    float v[64];
#pragma unroll
    for (int i = 0; i < 64; ++i) v[i] = src[(size_t)i * N];
    if (gain) {
#pragma unroll
        for (int i = 0; i < 64; ++i) v[i] *= gain[k0 + i];
    }
#pragma unroll
    for (int i = 0; i < 64; ++i) scr[i * 65 + lane] = v[i];
    LDS_WAIT(); asm volatile("" ::: "memory");
    const int c = lane & 7;
#pragma unroll
    for (int j = 0; j < 8; ++j) { const int n = (lane >> 3) + 8 * j; const LAS float* s = scr + (8 * c) * 65 + n;
        v4u o; o.x = pk2(s[0 * 65], s[1 * 65]); o.y = pk2(s[2 * 65], s[3 * 65]); o.z = pk2(s[4 * 65], s[5 * 65]); o.w = pk2(s[6 * 65], s[7 * 65]);
        *(GAS v4u*)(WT + (size_t)(d0 + n) * K + k0 + 8 * c) = o; }
    LDS_WAIT(); asm volatile("" ::: "memory");
}

__device__ __forceinline__ void convert_ffn(const Args& a, int f, LAS unsigned char* lds, int iw, int nw, int wave, int lane_) {
    int lane = lane_; asm volatile("" : "+v"(lane));
    LAS float* scr = (LAS float*)(lds + wave * 16640);
    const int l = f >> 1, which = f & 1; unsigned char* ws = a.ws;
    bf16* wb = (bf16*)(ws + WS_W + (size_t)f * W_FFN_STRIDE);
    const float* gain = a.in[which ? I_F2N : I_F1N] + l * D;
    for (int it = iw; it < 3 * 704; it += nw) {
        const int kind = it / 704, r = it - kind * 704;
        if (kind == 0) xpose_item(a.in[which ? I_F2G : I_F1G] + (size_t)l * D * FF, D, FF, gain, wb, 1, scr, r, lane);
        else if (kind == 1) xpose_item(a.in[which ? I_F2U : I_F1U] + (size_t)l * D * FF, D, FF, gain, wb, 2, scr, r, lane);
        else xpose_item(a.in[which ? I_F2D : I_F1D] + (size_t)l * D * FF, FF, D, nullptr, (bf16*)(ws + WS_W + (size_t)f * W_FFN_STRIDE + W_FFN_DOWN), 0, scr, r, lane);
    }
}
__device__ __forceinline__ void convert_small(const Args& a, int grp, LAS unsigned char* lds, int iw, int nw, int wave, int lane_) {
    int lane = lane_; asm volatile("" : "+v"(lane));
    LAS float* scr = (LAS float*)(lds + wave * 16640); unsigned char* ws = a.ws;
    for (int it = iw; it < 768; it += nw) {
        if (grp < 2) {
            if (it < 512) xpose_item(a.in[I_PW1] + (size_t)grp * D * 2 * D, D, 2 * D, a.in[I_MIXN] + grp * D, (bf16*)(ws + WS_WX + (size_t)grp * 4 * MiB), 3, scr, it, lane);
            else xpose_item(a.in[I_PW2] + (size_t)grp * D * D, D, D, nullptr, (bf16*)(ws + WS_WX + (12 + 2 * grp) * MiB), 0, scr, it - 512, lane);
        } else if (grp == 2) {
            if (it < 512) xpose_item(a.in[I_WKV], D, 2 * D, a.in[I_KVN], (bf16*)(ws + WS_WX + 8 * MiB), 0, scr, it, lane);
            else xpose_item(a.in[I_WQ], D, D, a.in[I_MIXN] + 2 * D, (bf16*)(ws + WS_WX + 16 * MiB), 0, scr, it - 512, lane);
        } else {
            if (it < 256) xpose_item(a.in[I_WO], D, D, nullptr, (bf16*)(ws + WS_WX + 20 * MiB), 0, scr, it, lane);
            else if (it < 512) xpose_item(a.in[I_WQ] + (size_t)D * D, D, D, a.in[I_MIXN] + 3 * D, (bf16*)(ws + WS_WX + 18 * MiB), 0, scr, it - 256, lane);
            else xpose_item(a.in[I_WO] + (size_t)D * D, D, D, nullptr, (bf16*)(ws + WS_WX + 22 * MiB), 0, scr, it - 512, lane);
        }
    }
}
__device__ __forceinline__ void prologue_phase(const Args& a, LAS unsigned char* lds, int vcu, int G, int wave, int lane) {
    LAS float* scr = (LAS float*)(lds + wave * 16640);
    const int gw = vcu * NWAVES + wave, NGW = G * NWAVES;
    unsigned char* ws = a.ws;
    convert_ffn(a, 0, lds, gw, NGW, wave, lane);
    float* ss = (float*)(ws + WS_SS); bf16* hb = (bf16*)(ws + WS_HB);
    const int rstart = (G == 256) ? (vcu >> 5) * (M / 8) + (vcu & 31) * NWAVES + wave : gw, rstep = (G == 256) ? 256 : NGW, rend = (G == 256) ? ((vcu >> 5) + 1) * (M / 8) : M;
    for (int m0 = rstart; m0 < rend; m0 += 4 * rstep) {
        f32x4 v[4][4];
#pragma unroll
        for (int q = 0; q < 4; ++q) { const int m = m0 + q * rstep; if (m < rend) { const GAS f32x4* xr = (const GAS f32x4*)(a.in[I_X] + (size_t)m * D) + lane;
#pragma unroll
            for (int j = 0; j < 4; ++j) v[q][j] = xr[64 * j]; } }
#pragma unroll
        for (int q = 0; q < 4; ++q) { const int m = m0 + q * rstep; if (m < rend) { float s = 0.f;
#pragma unroll
            for (int j = 0; j < 4; ++j) s += (v[q][j].x * v[q][j].x + v[q][j].y * v[q][j].y) + (v[q][j].z * v[q][j].z + v[q][j].w * v[q][j].w);
            s = wave_sum(s); if (lane < 16) ss[(size_t)m * 16 + lane] = (lane == 0) ? s : 0.f;
            GAS unsigned long long* o8 = (GAS unsigned long long*)(hb + (size_t)m * D) + lane;
#pragma unroll
            for (int j = 0; j < 4; ++j) o8[64 * j] = (unsigned long long)pk2(v[q][j].x, v[q][j].y) | ((unsigned long long)pk2(v[q][j].z, v[q][j].w) << 32); } }
    }
}

__device__ __forceinline__ void final_phase(float* out, const bf16* hb, const float* ss, const float* g, int vcu, int G, int wave, int lane) {
    const int gw = vcu * NWAVES + wave, NGW = G * NWAVES;
    f32x4 gv[2][2];
#pragma unroll
    for (int j = 0; j < 2; ++j) { gv[j][0] = *(const f32x4*)(g + 512 * j + 8 * lane); gv[j][1] = *(const f32x4*)(g + 512 * j + 8 * lane + 4); }
    const int rstart = (G == 256) ? (vcu >> 5) * (M / 8) + (vcu & 31) * NWAVES + wave : gw, rstep = (G == 256) ? 256 : NGW, rend = (G == 256) ? ((vcu >> 5) + 1) * (M / 8) : M;
    for (int m0 = rstart; m0 < rend; m0 += 4 * rstep) {
        float sq[4]; v4u hw[4][2];
#pragma unroll
        for (int q = 0; q < 4; ++q) { const int m = m0 + q * rstep; if (m < rend) { sq[q] = ss[(size_t)m * 16 + (lane & 15)];
#pragma unroll
            for (int j = 0; j < 2; ++j) hw[q][j] = *(const GAS v4u*)(hb + (size_t)m * D + 512 * j + 8 * lane); } }
#pragma unroll
        for (int q = 0; q < 4; ++q) { const int m = m0 + q * rstep; if (m < rend) { float t = sq[q]; t += __shfl_xor(t, 1); t += __shfl_xor(t, 2); t += __shfl_xor(t, 4); t += __shfl_xor(t, 8); const float rstd = __builtin_amdgcn_rsqf(t * (1.0f / D) + 1e-6f);
#pragma unroll
            for (int j = 0; j < 2; ++j) { const v4u w = hw[q][j];
                const f32x4 h0 = (f32x4){pg8::bf_lo(w.x), pg8::bf_hi(w.x), pg8::bf_lo(w.y), pg8::bf_hi(w.y)}, h1 = (f32x4){pg8::bf_lo(w.z), pg8::bf_hi(w.z), pg8::bf_lo(w.w), pg8::bf_hi(w.w)};
                GAS f32x4* o = (GAS f32x4*)(out + (size_t)m * D + 512 * j + 8 * lane); o[0] = h0 * rstd * gv[j][0]; o[1] = h1 * rstd * gv[j][1]; } } }
    }
}

__device__ __forceinline__ void dwconv_phase(const bf16* glu, bf16* cv, const float* wdw, const float* bdw, const float* lng, const float* lnb, LAS unsigned char* lds, int vcu, int G) {
    constexpr int TT = 16, NIN = TT + CW - 1, RS = 520;
    int tid_ = threadIdx.x; asm volatile("" : "+v"(tid_)); const int tid = tid_, c = 2 * tid;
    f32x2 w[CW];
#pragma unroll
    for (int j = 0; j < CW; ++j) w[j] = *(const f32x2*)(wdw + j * D + c);
    const f32x2 bd = *(const f32x2*)(bdw + c), gg = *(const f32x2*)(lng + c), bb = *(const f32x2*)(lnb + c);
    LAS float* red = (LAS float*)lds; LAS float* fin = (LAS float*)(lds + 2 * TT * RS * 4);
    const int ntile = M / TT, tstart = (G == 256) ? (vcu >> 5) * (ntile / 8) + (vcu & 31) : vcu, tstep = (G == 256) ? 32 : G, tend = (G == 256) ? ((vcu >> 5) + 1) * (ntile / 8) : ntile;
    for (int tile = tstart; tile < tend; tile += tstep) {
        const int m0 = tile * TT, t0 = m0 & (SEQ - 1);
        unsigned in[NIN];
#pragma unroll
        for (int i = 0; i < NIN; ++i) { in[i] = 0u; if (t0 - (CW - 1) + i >= 0) in[i] = *(const unsigned*)(glu + (size_t)(m0 - (CW - 1) + i) * D + c); }
        f32x2 o[TT];
#pragma unroll
        for (int t = 0; t < TT; ++t) o[t] = bd;
#pragma unroll
        for (int i = 0; i < NIN; ++i) { f32x2 x; x.x = __uint_as_float(in[i] << 16); x.y = __uint_as_float(in[i] & 0xffff0000u);
#pragma unroll
            for (int t = 0; t < TT; ++t) { const int j = i - t; if (j >= 0 && j < CW) o[t] += w[j] * x; } }
#pragma unroll
        for (int t = 0; t < TT; ++t) { red[(2 * t) * RS + tid] = o[t].x + o[t].y; red[(2 * t + 1) * RS + tid] = o[t].x * o[t].x + o[t].y * o[t].y; }
        __syncthreads();
        { const int v = tid >> 4, j = tid & 15; float s = 0.f;
#pragma unroll
          for (int i = 0; i < 32; ++i) s += red[v * RS + j + 16 * i];
          s += __shfl_xor(s, 8); s += __shfl_xor(s, 4); s += __shfl_xor(s, 2); s += __shfl_xor(s, 1);
          if (j == 0) fin[v] = s; }
        __syncthreads();
#pragma unroll
        for (int t = 0; t < TT; ++t) { const float mean = fin[2 * t] * (1.0f / D), var = fin[2 * t + 1] * (1.0f / D) - mean * mean, rstd = __builtin_amdgcn_rsqf(var + 1e-5f);
            f32x2 y = (o[t] - mean) * rstd * gg + bb; y.x = y.x * pg8::fast_sigmoid(y.x); y.y = y.y * pg8::fast_sigmoid(y.y);
            *(unsigned*)(cv + (size_t)(m0 + t) * D + c) = pk2(y.x, y.y); }
    }
    __syncthreads();
}

namespace sba {
typedef short s16x4 __attribute__((ext_vector_type(4)));
typedef float f32x16 __attribute__((ext_vector_type(16)));
typedef short v4i16_t __attribute__((ext_vector_type(4)));
typedef LAS const char* lds_cptr;
__device__ __forceinline__ int crow(int r, int hi) { return (r & 3) + 8 * (r >> 2) + 4 * hi; }
__device__ __forceinline__ s16x4 vtr(lds_cptr p) { return __builtin_bit_cast(s16x4, __builtin_amdgcn_ds_read_tr16_b64_v4i16((LAS v4i16_t*)p)); }

constexpr float FSTOP = 5.9604644775e-08f;
__device__ __forceinline__ void attn_item5(int b, int h, int qblk, const bf16* Q, const bf16* __restrict__ K, const bf16* __restrict__ V, bf16* O, LAS unsigned char* wl  , int lane) {
    const int r32 = lane & 31, hi = lane >> 5;
    const long rowbase = (long)b * SEQ; const int t0 = qblk * 32;
    const int rl = lane >> 3, cl = (lane & 7) ^ rl;
    const bf16* qsrc = Q + (rowbase + t0 + rl) * D + h * HD + cl * 8;
    const bf16* ksrc = K + (rowbase + rl) * D + h * HD + cl * 8;
    const bf16* vsrc = V + rowbase * D + h * HD + (long)(lane >> 2) * D + (lane & 3) * 8;
#define SB_RDMA(src_, ldsoff_) do { _Pragma("unroll") for (int i_ = 0; i_ < 4; ++i_) \
        __builtin_amdgcn_global_load_lds((const unsigned*)((src_) + (long)(8 * i_) * D), (LAS unsigned*)(wl + (ldsoff_) + i_ * 1024), 16, 0, 0); } while (0)
#define SB_VDMA(j_, slot_) do { _Pragma("unroll") for (int c_ = 0; c_ < 4; ++c_) \
        __builtin_amdgcn_global_load_lds((const unsigned*)(vsrc + (long)((j_) * 32 + 16 * (c_ & 1)) * D + (c_ >> 1) * 32), (LAS unsigned*)(wl + (slot_) * 4096 + c_ * 1024), 16, 0, 0); } while (0)
    const lds_cptr l3 = (lds_cptr)wl;
    const lds_cptr vp0 = l3 + ((lane >> 4) & 1) * 32 + (lane & 3) * 8 + (4 * hi + ((lane & 15) >> 2)) * 64;
    int foff[4];
#pragma unroll
    for (int d0 = 0; d0 < 4; ++d0) foff[d0] = (r32 >> 3) * 1024 + (r32 & 7) * 128 + (((2 * d0 + hi) ^ (r32 & 7)) * 16);
    const int j0 = qblk;
    SB_RDMA(ksrc + (long)j0 * 32 * D, 8192); SB_VDMA(j0, 0); SB_RDMA(qsrc, 12288);
    VM_WAIT();
    bf16x8 qr[4];
#pragma unroll
    for (int d0 = 0; d0 < 4; ++d0) qr[d0] = *(const LAS bf16x8*)(l3 + 12288 + foff[d0]);
    LDS_WAIT();
    if (j0 >= 1) { SB_RDMA(ksrc + (long)(j0 - 1) * 32 * D, 12288); SB_VDMA(j0 - 1, 1); }
    f32x16 o[2]; o[0] = f32x16{}; o[1] = f32x16{};
    float F = 1.0f;
    const int qpos = t0 + r32;
    for (int j = j0; j >= 0; --j) {
        const int slot = (j0 - j) & 1;
        if (j >= 1) asm volatile("s_waitcnt vmcnt(8)" ::: "memory"); else asm volatile("s_waitcnt vmcnt(0)" ::: "memory");
        bf16x8 kf[4];
#pragma unroll
        for (int d0 = 0; d0 < 4; ++d0) kf[d0] = *(const LAS bf16x8*)(l3 + 8192 + slot * 4096 + foff[d0]);
        f32x16 p = __builtin_amdgcn_mfma_f32_32x32x16_bf16(kf[0], qr[0], f32x16{}, 0, 0, 0);
#pragma unroll
        for (int d0 = 1; d0 < 4; ++d0) p = __builtin_amdgcn_mfma_f32_32x32x16_bf16(kf[d0], qr[d0], p, 0, 0, 0);
        const bool diag = (j == j0);
        float beta[16], om[16];
#pragma unroll
        for (int r = 0; r < 16; ++r) { const float e = __builtin_amdgcn_exp2f(-p[r]); float bt = __builtin_amdgcn_rcpf(1.0f + e); float m1 = 1.0f - bt;
            if (diag) { const int kv = 32 * j + crow(r, hi); if (kv >= qpos) { bt = 0.f; m1 = 1.f; } }
            beta[r] = bt; om[r] = m1; }
        float A1[4], A0[4], T[4], PT[4];
#pragma unroll
        for (int g = 0; g < 4; ++g) { A1[g] = om[4 * g + 3] * om[4 * g + 2]; A0[g] = A1[g] * om[4 * g + 1]; T[g] = A0[g] * om[4 * g]; }
#pragma unroll
        for (int g = 0; g < 4; ++g) PT[g] = __shfl_xor(T[g], 32);
        float X = 1.f, carry[4];
#pragma unroll
        for (int g = 3; g >= 0; --g) { carry[g] = F * X * (hi == 0 ? PT[g] : 1.f); X *= T[g] * PT[g]; }
        F *= X;
        unsigned pw[2][4];
#pragma unroll
        for (int g = 0; g < 4; ++g) { const float w3 = beta[4 * g + 3] * carry[g], w2 = beta[4 * g + 2] * (carry[g] * om[4 * g + 3]), w1 = beta[4 * g + 1] * (carry[g] * A1[g]), w0 = beta[4 * g] * (carry[g] * A0[g]);
            pw[g >> 1][(g & 1) * 2] = pk2(w0, w1); pw[g >> 1][(g & 1) * 2 + 1] = pk2(w2, w3); }
        const lds_cptr vp = vp0 + slot * 4096;
#pragma unroll
        for (int d0 = 0; d0 < 2; ++d0)
#pragma unroll
            for (int ks = 0; ks < 2; ++ks) { const s16x4 lo = vtr(vp + d0 * 2048 + ks * 1024), hh = vtr(vp + d0 * 2048 + ks * 1024 + 512);
                const bf16x8 vf = (bf16x8){lo[0], lo[1], lo[2], lo[3], hh[0], hh[1], hh[2], hh[3]};
                const v4u pa = (v4u){pw[ks][0], pw[ks][1], pw[ks][2], pw[ks][3]};
                o[d0] = __builtin_amdgcn_mfma_f32_32x32x16_bf16(__builtin_bit_cast(bf16x8, pa), vf, o[d0], 0, 0, 0); }
        if (__all(F < FSTOP)) break;
        LDS_WAIT();
        if (j >= 2) { SB_RDMA(ksrc + (long)(j - 2) * 32 * D, 8192 + slot * 4096); SB_VDMA(j - 2, slot); }
    }
    VM_WAIT(); LDS_WAIT();
    { LAS bf16* stg = (LAS bf16*)wl;
      bf16* Ow = O + (rowbase + t0) * D + h * HD;
#pragma unroll
      for (int r = 0; r < 16; ++r) { const int orow = crow(r, hi);
#pragma unroll
          for (int d0 = 0; d0 < 2; ++d0) stg[orow * 64 + d0 * 32 + r32] = (bf16)(pk2(o[d0][r], 0.f) & 0xffffu); }
      LDS_WAIT();
#pragma unroll
      for (int i = 0; i < 4; ++i) { const int row = i * 8 + (lane >> 3), ch = lane & 7; const v4u v = *(const LAS v4u*)(stg + row * 64 + ch * 8); *(v4u*)(Ow + (long)row * D + ch * 8) = v; } }
    LDS_WAIT();
#undef SB_RDMA
#undef SB_VDMA
}
__device__ __forceinline__ void attn_phase_v4(const bf16* Q, const bf16* K, const bf16* V, bf16* O, LAS unsigned char* lds, int vcu, int G) {
    int tid_ = threadIdx.x; asm volatile("" : "+v"(tid_)); const int lane = tid_ & 63, wid = __builtin_amdgcn_readfirstlane(tid_ >> 6);
    LAS unsigned char* wl = lds + wid * 16384;
    if (G == 256) {
        const int xb = vcu >> 5, lw = (vcu & 31) * NWAVES + wid;
        for (int i = 0; i < 4; ++i) { const int v = lw + 256 * i; attn_item5(xb, v & 15, 63 - (v >> 4), Q, K, V, O, wl, lane); }
    } else {
        const int NITEM = BATCH * NH * (SEQ / 32);
        for (int u = vcu * NWAVES + wid; u < NITEM; u += G * NWAVES) { const int bh = u & 127, qblk = 63 - (u >> 7); attn_item5(bh / NH, bh % NH, qblk, Q, K, V, O, wl, lane); }
    }
    __syncthreads();
}
}

#define XB_TMO      128
#define XB_XCNT(j)  (256  + 64 * (j))
#define XB_XSUB(j)  (1280 + 64 * (j))
#define XB_XGEN(j)  (2304 + 64 * (j))
#define XB_TOP      3328
#define XB_TOPGEN   3392
#define XCD_BAR_WORDS 3456
#define XB_SPIN_CAP (1u << 18)

__device__ __forceinline__ unsigned xb_ld(unsigned* p)              { return __hip_atomic_load(p, __ATOMIC_RELAXED, __HIP_MEMORY_SCOPE_AGENT); }
__device__ __forceinline__ unsigned xb_add(unsigned* p, unsigned v) { return __hip_atomic_fetch_add(p, v, __ATOMIC_RELAXED, __HIP_MEMORY_SCOPE_AGENT); }
__device__ __forceinline__ unsigned xb_xcc_id() { return (unsigned)__builtin_amdgcn_s_getreg((3 << 11) | 20) & 0xFu; }
#define XB_SPIN(cond, bar) do { unsigned _sp = 0; while (cond) { __builtin_amdgcn_s_sleep(1); \
    if ((++_sp & 255u) == 0u) { if (xb_ld(&(bar)[XB_TMO])) break; if (_sp > XB_SPIN_CAP) { atomicAdd(&(bar)[XB_TMO], 1u); break; } } } } while (0)

struct XcdBarrier {
    unsigned* bar; unsigned x;
    volatile LAS unsigned* st;
};

__device__ __forceinline__ XcdBarrier xcd_barrier_post(unsigned* bar, volatile LAS unsigned* st) {
    XcdBarrier b; b.bar = bar; b.x = xb_xcc_id(); b.st = st;
    if (threadIdx.x == 0) (void)xb_add(&bar[XB_XCNT(b.x)], 1u);
    return b;
}
__device__ __forceinline__ void xcd_barrier_complete(unsigned* bar, unsigned x, unsigned& nloc, unsigned& nx) {
    const unsigned G = gridDim.x * gridDim.y * gridDim.z;
    unsigned sum, cnt, mine, sp = 0u;
    for (;;) {
        sum = 0u; cnt = 0u; mine = 0u;
#pragma unroll
        for (unsigned j = 0; j < 16; ++j) { const unsigned c = xb_ld(&bar[XB_XCNT(j)]); sum += c; cnt += (c > 0u) ? 1u : 0u; mine = (j == x) ? c : mine; }
        if (sum == G) break;
        __builtin_amdgcn_s_sleep(1);
        if ((++sp & 255u) == 0u) { if (xb_ld(&bar[XB_TMO])) break; if (sp > XB_SPIN_CAP) { atomicAdd(&bar[XB_TMO], 1u); break; } }
    }
    nloc = mine > 0u ? mine : 1u; nx = cnt > 0u ? cnt : 1u;
}

__device__ __forceinline__ void xcd_barrier(const XcdBarrier& b) {
    asm volatile("s_waitcnt vmcnt(0)" ::: "memory");
    __syncthreads();
    if (threadIdx.x == 0) {
        unsigned* bar = b.bar;
        __builtin_amdgcn_s_waitcnt(0);
        unsigned nloc = b.st[0], nx = b.st[1];
        if (nloc == 0u) { xcd_barrier_complete(bar, b.x, nloc, nx); b.st[0] = nloc; b.st[1] = nx; }
        const unsigned old = xb_add(&bar[XB_XSUB(b.x)], 1u);
        const unsigned gen = old / nloc;
        if (old + 1u == (gen + 1u) * nloc) {
            __builtin_amdgcn_fence(__ATOMIC_RELEASE, "agent");
            asm volatile("s_waitcnt vmcnt(0)" ::: "memory");
            const unsigned og = xb_add(&bar[XB_TOP], 1u);
            const unsigned tg = og / nx;
            if (og + 1u == (tg + 1u) * nx) xb_add(&bar[XB_TOPGEN], 1u);
            else XB_SPIN(xb_ld(&bar[XB_TOPGEN]) == tg, bar);
            __builtin_amdgcn_fence(__ATOMIC_ACQUIRE, "agent");
            xb_add(&bar[XB_XGEN(b.x)], 1u);
            asm volatile("s_waitcnt vmcnt(0)" ::: "memory");
        } else {
            XB_SPIN(xb_ld(&bar[XB_XGEN(b.x)]) == gen, bar);
            __builtin_amdgcn_fence(__ATOMIC_ACQUIRE, "agent");
            asm volatile("s_waitcnt vmcnt(0)" ::: "memory");
        }
    }
    __syncthreads();
}

__global__ void __launch_bounds__(NTHR, 2) mk_fwd(Args a) {
    extern __shared__ __attribute__((aligned(16))) unsigned char lds_raw[];
    cg::grid_group grid = cg::this_grid();
    LAS unsigned char* lds = (LAS unsigned char*)lds_raw;
    const int tid = threadIdx.x, lane = tid & 63, wave = __builtin_amdgcn_readfirstlane(tid >> 6);
    const int G = gridDim.x, bx = blockIdx.x; const int vcu = (G % 8 == 0) ? (bx % 8) * (G / 8) + bx / 8 : bx;
    unsigned char* ws = a.ws;
    float* ss = (float*)(ws + WS_SS); bf16* hb = (bf16*)(ws + WS_HB); bf16* KB = (bf16*)(ws + WS_K); bf16* VB = (bf16*)(ws + WS_V);
    bf16* ACT = (bf16*)(ws + WS_ACT); bf16* B0 = ACT; bf16* B1 = (bf16*)(ws + WS_ACT + 32 * MiB);
    float* h = a.out;
    volatile LAS unsigned* xst = (volatile LAS unsigned*)(lds + LDS_BYTES - 64);
    if (tid < 4) xst[tid] = 0u;
    __syncthreads();
    XcdBarrier xbar = xcd_barrier_post((unsigned*)ws, xst);

#ifndef DBG_STOP
#define DBG_STOP 0
#endif
#ifndef DBG_SRC
#define DBG_SRC 5
#endif
    int nsync = 0;
#ifdef DUP_SYNC
#define DUP_SYNC_BODY xcd_barrier(xbar);
#else
#define DUP_SYNC_BODY
#endif
#define GRID_SYNC() do { xcd_barrier(xbar); \
        DUP_SYNC_BODY \
        if (DBG_STOP && ++nsync == DBG_STOP) { const bf16* src_ = DBG_SRC == 0 ? hb : DBG_SRC == 1 ? B0 : DBG_SRC == 2 ? B1 : DBG_SRC == 3 ? KB : VB; \
            for (size_t i_ = (size_t)bx * NTHR + tid; i_ < (size_t)M * D; i_ += (size_t)G * NTHR) { float v_ = __uint_as_float((unsigned)((DBG_SRC == 5) ? hb[i_] : src_[i_]) << 16); if (!(__builtin_fabsf(v_) < 1e30f)) v_ = 12345.0f; h[i_] = v_; } return; } } while (0)
#ifdef DUP_PRO
    prologue_phase(a, lds, vcu, G, wave, lane); __syncthreads();
#endif
    prologue_phase(a, lds, vcu, G, wave, lane);
    GRID_SYNC();

#ifndef GEMM_SP2
#define GEMM_SP2 true
#endif
#ifndef GEMM_ALIGN
#define GEMM_ALIGN true
#endif
#define GEMM(EpiT, Aptr, Bptr, N_, K_, epi) do { pg8::Gemm g_{(const bf16*)(Aptr), (const bf16*)(Bptr), M, (N_), (K_)}; pg8::StaticOrder S_; S_.init(M, (N_), G, bx); \
        pg8::gemm_phase<EpiT, pg8::StaticOrder, GEMM_ALIGN, GEMM_SP2>(lds, g_, S_, epi); } while (0)

    for (int l = 0; l < 4; ++l) {
        for (int which = 0; which < 2; ++which) {
            const int f = 2 * l + which;
            if (which == 1) {
                if (l < 2) {
                    { pg8::EpiGated<1> E{B0, D, ss + (3 * l + 1) * SSM, a.in[I_BPW1] + l * 2 * D, a.in[I_BPW1] + l * 2 * D + D}; GEMM(pg8::EpiGated<1>, hb, ws + WS_WX + (size_t)l * 4 * MiB, 2 * D, D, E); }
                    GRID_SYNC();
#ifdef DUP_DW
                    dwconv_phase(B0, B1, a.in[I_WDW] + l * CW * D, a.in[I_BDW] + l * D, a.in[I_LNG] + l * D, a.in[I_LNB] + l * D, lds, vcu, G);
#endif
                    dwconv_phase(B0, B1, a.in[I_WDW] + l * CW * D, a.in[I_BDW] + l * D, a.in[I_LNG] + l * D, a.in[I_LNB] + l * D, lds, vcu, G);
                    GRID_SYNC();
                    { pg8::EpiResid E{hb, ss + (3 * l + 2) * SSM, a.in[I_BPW2] + l * D, 1.0f}; GEMM(pg8::EpiResid, B1, ws + WS_WX + (12 + 2 * l) * MiB, D, D, E); }
                    GRID_SYNC();
                } else {
                    const int i = l - 2;
                    { pg8::EpiScaleBf16 E{B0, D, ss + (3 * l + 1) * SSM, 0, 0, 0.125f * pg8::LOG2E}; GEMM(pg8::EpiScaleBf16, hb, ws + WS_WX + (16 + 2 * i) * MiB, D, D, E); }
                    GRID_SYNC();
#ifdef DUP_ATT
                    sba::attn_phase_v4(B0, KB, VB, B1, lds, vcu, G);
#endif
                    sba::attn_phase_v4(B0, KB, VB, B1, lds, vcu, G);
                    GRID_SYNC();
                    { pg8::EpiResid E{hb, ss + (3 * l + 2) * SSM, nullptr, 1.0f}; GEMM(pg8::EpiResid, B1, ws + WS_WX + (20 + 2 * i) * MiB, D, D, E); }
                    GRID_SYNC();
                }
            }
            const int si = 3 * l + (which ? 2 : 0);
#ifdef DUP_GU
            { pg8::EpiGated<0> E{ACT, (a.ws != nullptr) ? -FF : FF, ss + si * SSM, nullptr, nullptr}; GEMM(pg8::EpiGated<0>, hb, ws + WS_W + (size_t)f * W_FFN_STRIDE, 2 * FF, D, E); }
#endif
            { pg8::EpiGated<0> E{ACT, FF, ss + si * SSM, nullptr, nullptr}; GEMM(pg8::EpiGated<0>, hb, ws + WS_W + (size_t)f * W_FFN_STRIDE, 2 * FF, D, E); }
            if (l == 2 && which == 0) {
                pg8::EpiScaleBf16 E{KB, D, ss + si * SSM, D, (size_t)(WS_V - WS_K) / 2, 1.0f}; GEMM(pg8::EpiScaleBf16, hb, ws + WS_WX + 8 * MiB, 2 * D, D, E);
            }
            if (G == 256) {
                if (bx >= 128) { if (f < 7) convert_ffn(a, f + 1, lds, (bx - 128) * NWAVES + wave, 128 * NWAVES, wave, lane); if (f < 4) convert_small(a, f, lds, 1023 - ((bx - 128) * NWAVES + wave), 128 * NWAVES, wave, lane); }
            } else {
                if (f < 7) convert_ffn(a, f + 1, lds, bx * NWAVES + wave, G * NWAVES, wave, lane); if (f < 4) convert_small(a, f, lds, bx * NWAVES + wave, G * NWAVES, wave, lane);
            }
            GRID_SYNC();
#ifdef DUP_DOWN
            if (f > 0)             { pg8::EpiResid E{hb, ss + (si + 1) * SSM, nullptr, 0.0f}; GEMM(pg8::EpiResid, ACT, ws + WS_W + (size_t)f * W_FFN_STRIDE + W_FFN_DOWN, D, FF, E); }
#endif
            { pg8::EpiResid E{hb, ss + (si + 1) * SSM, nullptr, 0.5f}; GEMM(pg8::EpiResid, ACT, ws + WS_W + (size_t)f * W_FFN_STRIDE + W_FFN_DOWN, D, FF, E); }
            GRID_SYNC();
        }
    }
    final_phase(a.out, hb, ss + 12 * SSM, a.in[I_FINN], vcu, G, wave, lane);
    asm volatile("s_waitcnt vmcnt(0)" ::: "memory"); __syncthreads(); grid.sync();
}

extern "C" void kernel_launch(void* const* d_in, const int* in_sizes, int n_in, void* d_out, int out_size, void* d_ws, size_t ws_size, hipStream_t stream) {
    static int grid = 0;
    if (grid == 0) {
        if (n_in != 23 || in_sizes[0] != M * D || out_size != M * D || ws_size < WS_END) { fprintf(stderr, "kernel_launch: unexpected shapes (n_in %d, in0 %d, out %d, ws %zu < %zu)\n", n_in, n_in > 0 ? in_sizes[0] : -1, out_size, ws_size, (size_t)WS_END); grid = -1; return; }
        int dev = 0, cus = 0, per_cu = 0;
        if (hipGetDevice(&dev) != hipSuccess || hipDeviceGetAttribute(&cus, hipDeviceAttributeMultiprocessorCount, dev) != hipSuccess) { grid = -1; return; }
        if (hipFuncSetAttribute((const void*)mk_fwd, hipFuncAttributeMaxDynamicSharedMemorySize, LDS_BYTES) != hipSuccess) { fprintf(stderr, "kernel_launch: hipFuncSetAttribute failed\n"); grid = -1; return; }
        if (hipOccupancyMaxActiveBlocksPerMultiprocessor(&per_cu, (const void*)mk_fwd, NTHR, LDS_BYTES) != hipSuccess || per_cu < 1) { fprintf(stderr, "kernel_launch: occupancy query says %d\n", per_cu); per_cu = 1; }
        (void)hipGetLastError();
        grid = cus;
    }
    if (grid < 0) return;
    if (hipMemsetAsync(d_ws, 0, 16384, stream) != hipSuccess) { fprintf(stderr, "kernel_launch: hipMemsetAsync failed\n"); return; }
    Args a{};
    for (int i = 0; i < 23; ++i) a.in[i] = (const float*)d_in[i];
    a.out = (float*)d_out; a.ws = (unsigned char*)d_ws;
    void* args[] = {&a};
    hipError_t e = hipLaunchCooperativeKernel((const void*)mk_fwd, dim3(grid), dim3(NTHR), args, LDS_BYTES, stream);
    if (e != hipSuccess) fprintf(stderr, "cooperative launch failed: %s (grid %d)\n", hipGetErrorString(e), grid);
}
```
